# Optimizing an MI355X kernel written in HIP

```python
import math
import jax, jax.numpy as jnp
from jax import lax
import numpy as np

D_MODEL = 2048
BATCH = 4
SEQ = 2048
DEPTH = 2
DEC_BATCH = 128
DEC_SEQ = 8
PAST_LEN = 16384
PAGE_SIZE = 128

N_EVEN = (DEPTH + 1) // 2
N_ODD = DEPTH // 2
M_HEADS = 4
M_HEAD_DIM = D_MODEL // 8
M_WIDTH = M_HEADS * M_HEAD_DIM
M_CONV = 4
G_HEADS = 8
G_HEAD_DIM = D_MODEL // 16
G_WIDTH = G_HEADS * G_HEAD_DIM
MIX_WIDTH = M_WIDTH + G_WIDTH
IN_SIZES = (M_WIDTH,) * 4 + (M_HEADS,) * 2 + (G_WIDTH,) * 4
IN_WIDTH = 4 * M_WIDTH + 2 * M_HEADS + 4 * G_WIDTH
R_HEAD_DIM = 64
R_HEADS = D_MODEL // R_HEAD_DIM
R_DECAY_LORA = 96
R_AAA_LORA = 96
R_GATE_LORA = 256
D_FF = 4 * D_MODEL
N_MOD = 6
CHUNK = 64
RMS_EPS = 1e-6
LN_X_EPS = 64e-5
F32 = jnp.float32

kernel_name = 'xlstm_hgrn2_rwkv7_hybrid_step'


def rmsnorm(x, g):
    x32 = x.astype(F32)
    y = x32 * lax.rsqrt(jnp.mean(x32 * x32, axis=-1, keepdims=True) + RMS_EPS)
    return (y * g.astype(F32)).astype(x.dtype)


def head_rms(y):
    return y * lax.rsqrt(jnp.mean(y * y, axis=-1, keepdims=True) + RMS_EPS)


def head_ln(y, eps):
    d = y - jnp.mean(y, axis=-1, keepdims=True)
    return d * lax.rsqrt(jnp.mean(d * d, axis=-1, keepdims=True) + eps)


def causal_conv(u, buf, w):
    T = u.shape[1]
    K = w.shape[0]
    ext = jnp.concatenate([buf.astype(u.dtype), u], axis=1)
    out = ext[:, K - 1:K - 1 + T] * w[K - 1]
    for j in range(K - 1):
        out = out + ext[:, j:j + T] * w[j]
    return out, ext[:, T:]


def to_chunks(a, L):
    B, T = a.shape[:2]
    return jnp.moveaxis(a.reshape((B, T // L, L) + a.shape[2:]), 1, 0)


def from_chunks(a):
    NC, B, L = a.shape[:3]
    return jnp.moveaxis(a, 0, 1).reshape((B, NC * L) + a.shape[3:])


def mlstm_chunkwise(q, k, v, ig, lf, C0, n0, m0):
    T = q.shape[1]
    L = math.gcd(T, CHUNK)
    mask = jnp.tril(jnp.ones((L, L), dtype=bool))[None, :, :, None]

    def step(carry, xs):
        C, n, m = carry
        qc, kc, vc, ic, fc = xs
        b = jnp.cumsum(fc, axis=1)
        dmat = b[:, :, None, :] - b[:, None, :, :] + ic[:, None, :, :]
        dmat = jnp.where(mask, dmat, -jnp.inf)
        inter = b + m[:, None, :]
        m_t = jnp.maximum(inter, jnp.max(dmat, axis=2))
        w_intra = jnp.exp(dmat - m_t[:, :, None, :])
        w_inter = jnp.exp(inter - m_t)
        s = jnp.einsum('bthd,bshd->btsh', qc, kc) * w_intra
        num = jnp.einsum('btsh,bshe->bthe', s, vc) + w_inter[..., None] * jnp.einsum('bthd,bhde->bthe', qc, C)
        den = jnp.sum(s, axis=2) + w_inter * jnp.einsum('bthd,bhd->bth', qc, n)
        h = num / jnp.maximum(jnp.abs(den), jnp.exp(-m_t))[..., None]
        m_new = m_t[:, -1]
        w_end = jnp.exp(b[:, -1:, :] - b + ic - m_new[:, None, :])
        decay = jnp.exp(b[:, -1] + m - m_new)
        C = decay[..., None, None] * C + jnp.einsum('bsh,bshd,bshe->bhde', w_end, kc, vc)
        n = decay[..., None] * n + jnp.einsum('bsh,bshd->bhd', w_end, kc)
        return (C, n, m_new), h

    xs = tuple(to_chunks(t, L) for t in (q, k, v, ig, lf))
    (C, n, m), hs = lax.scan(step, (C0, n0, m0), xs)
    return from_chunks(hs), C, n, m


def hgrn2_chunkwise(q, k, v, lg, S0):
    T = q.shape[1]
    L = math.gcd(T, CHUNK)
    mask = jnp.tril(jnp.ones((L, L), dtype=bool))[None, :, :, None, None]

    def step(S, xs):
        qc, kc, vc, gc = xs
        bc = jnp.cumsum(gc, axis=1)
        diff = jnp.where(mask, bc[:, :, None] - bc[:, None, :], -jnp.inf)
        A = jnp.einsum('btshk,bshk->btsh', qc[:, :, None] * jnp.exp(diff), kc)
        o = jnp.einsum('btsh,bshv->bthv', A, vc) + jnp.einsum('bthk,bhkv->bthv', qc * jnp.exp(bc), S)
        bl = bc[:, -1]
        S = jnp.exp(bl)[..., None] * S + jnp.einsum('bshk,bshv->bhkv', kc * jnp.exp(bl[:, None] - bc), vc)
        return S, o

    xs = tuple(to_chunks(t, L) for t in (q, k, v, lg))
    S, os_ = lax.scan(step, S0, xs)
    return from_chunks(os_), S


def rwkv7_recurrence(r, w, k, v, a, b, S0):
    def step(S, xs):
        rt, wt, kt, vt, at, bt = xs
        sa = jnp.einsum('bhij,bhj->bhi', S, at)
        S = S * wt[:, :, None, :] + sa[..., None] * bt[:, :, None, :] + vt[..., None] * kt[:, :, None, :]
        return S, jnp.einsum('bhij,bhj->bhi', S, rt)

    xs = tuple(jnp.moveaxis(t, 1, 0) for t in (r, w, k, v, a, b))
    S, ys = lax.scan(step, S0, xs)
    return jnp.moveaxis(ys, 0, 1), S


def ab_mixer(h, W_in, gate_b, conv_w, m_gain, lb, g_gain, W_out, C0, n0, m0, conv0, S0):
    B, T, _ = h.shape
    z = h @ W_in
    idx = np.cumsum(IN_SIZES)[:-1].tolist()
    mq, mk, mv, mo, mi, mf, gq, gf, gi, gg = jnp.split(z, idx, axis=-1)
    qk, conv_new = causal_conv(jnp.concatenate([mq, mk], axis=-1), conv0, conv_w)
    qk = jax.nn.silu(qk.astype(F32))
    mhd = lambda t: t.reshape(B, T, M_HEADS, M_HEAD_DIM)
    q = mhd(qk[..., :M_WIDTH])
    k = mhd(qk[..., M_WIDTH:]) * (M_HEAD_DIM ** -0.5)
    v = mhd(mv.astype(F32))
    ig = mi.astype(F32) + gate_b[:M_HEADS].astype(F32)
    lf = jax.nn.log_sigmoid(mf.astype(F32) + gate_b[M_HEADS:].astype(F32))
    hm, C, n, m = mlstm_chunkwise(q, k, v, ig, lf, C0.astype(F32), n0.astype(F32), m0.astype(F32))
    hm = jax.nn.sigmoid(mhd(mo.astype(F32))) * head_ln(hm, RMS_EPS) * m_gain.astype(F32).reshape(M_HEADS, M_HEAD_DIM)
    ghd = lambda t: t.reshape(B, T, G_HEADS, G_HEAD_DIM)
    gq_ = ghd(jax.nn.silu(gq.astype(F32))) * (G_HEAD_DIM ** -0.5)
    f = lb + (1.0 - lb) * jax.nn.sigmoid(gf.astype(F32))
    og, S = hgrn2_chunkwise(gq_, ghd(1.0 - f), ghd(gi.astype(F32)), ghd(jnp.log(f)), S0.astype(F32))
    og = head_rms(og) * g_gain.astype(F32).reshape(G_HEADS, G_HEAD_DIM) * ghd(jax.nn.silu(gg.astype(F32)))
    mixed = jnp.concatenate([hm.reshape(B, T, M_WIDTH), og.reshape(B, T, G_WIDTH)], axis=-1).astype(h.dtype)
    return mixed @ W_out, C, n, m, conv_new, S


def rwkv7_mixer(h, shift0, S0, mu, w0, w1, w2, a0, a1, a2, g1, g2, k_k, k_a, r_k, W_r, W_k, W_v, W_o, ln_w, ln_b):
    B, T, _ = h.shape
    prev = jnp.concatenate([shift0[:, None, :].astype(h.dtype), h[:, :-1]], axis=1)
    xx = prev - h
    xr, xw, xk, xv, xa, xg = (h + xx * mu[i] for i in range(6))
    r = (xr @ W_r).astype(F32)
    k = (xk @ W_k).astype(F32)
    v = (xv @ W_v).astype(F32)
    w = -jax.nn.softplus(-(w0.astype(F32) + (jnp.tanh(xw @ w1) @ w2).astype(F32))) - 0.5
    a = jax.nn.sigmoid(a0.astype(F32) + ((xa @ a1) @ a2).astype(F32))
    g = jax.nn.sigmoid(xg @ g1) @ g2
    hd = lambda t: t.reshape(B, T, R_HEADS, R_HEAD_DIM)
    kk = hd(k * k_k.astype(F32))
    kk = kk / jnp.maximum(jnp.linalg.norm(kk, axis=-1, keepdims=True), 1e-12)
    k = k * (1.0 + (a - 1.0) * k_a.astype(F32))
    decay = jnp.exp(-jnp.exp(w))
    r4, k4, v4, a4 = hd(r), hd(k), hd(v), hd(a)
    y, S = rwkv7_recurrence(r4, hd(decay), k4, v4, -kk, kk * a4, S0.astype(F32))
    y = head_ln(y, LN_X_EPS).reshape(B, T, D_MODEL) * ln_w.astype(F32) + ln_b.astype(F32)
    bonus = jnp.sum(r4 * k4 * r_k.astype(F32), axis=-1, keepdims=True) * v4
    y = y + bonus.reshape(B, T, D_MODEL)
    out = (y.astype(h.dtype) * g) @ W_o
    return out, S, h[:, -1]


def trunk(x, c, m_C, m_n, m_m, m_conv, g_S, r_S, r_shift, p):
    B = x.shape[0]
    sc = jax.nn.silu(c)
    lbs = jnp.cumsum(jax.nn.softmax(p['g_lb'].astype(F32), axis=0), axis=0)
    outC, outn, outm, outconv, outS, outrS, outsh = [], [], [], [], [], [], []
    for l in range(DEPTH):
        mod = (sc @ p['mod_w'][l] + p['mod_b'][l]).reshape(B, N_MOD, D_MODEL)
        sh1, sc1, gt1, sh2, sc2, gt2 = (mod[:, i, None, :] for i in range(N_MOD))
        h = rmsnorm(x, p['norm_mix'][l]) * (1.0 + sc1) + sh1
        j = l // 2
        if l % 2 == 0:
            out, C, n, m, conv, S = ab_mixer(h, p['ab_w_in'][j], p['ab_gate_b'][j], p['m_conv_w'][j], p['m_norm'][j],
                                             lbs[j], p['g_norm'][j], p['ab_w_out'][j],
                                             m_C[j], m_n[j], m_m[j], m_conv[j], g_S[j])
            outC.append(C); outn.append(n); outm.append(m); outconv.append(conv); outS.append(S)
        else:
            out, S, sh = rwkv7_mixer(h, r_shift[j], r_S[j], p['r_mu'][j], p['r_w0'][j], p['r_w1'][j], p['r_w2'][j],
                                     p['r_a0'][j], p['r_a1'][j], p['r_a2'][j], p['r_g1'][j], p['r_g2'][j],
                                     p['r_kk'][j], p['r_ka'][j], p['r_rk'][j], p['r_wr'][j], p['r_wk'][j],
                                     p['r_wv'][j], p['r_wo'][j], p['r_lnw'][j], p['r_lnb'][j])
            outrS.append(S); outsh.append(sh)
        x = x + (gt1 * out).astype(x.dtype)
        h = rmsnorm(x, p['norm_ffn'][l]) * (1.0 + sc2) + sh2
        ff = jnp.square(jax.nn.relu(h @ p['ffn_w1'][l])) @ p['ffn_w2'][l]
        x = x + (gt2 * ff).astype(x.dtype)
    y = rmsnorm(x, p['final_norm'])
    return y, (jnp.stack(outC), jnp.stack(outn), jnp.stack(outm), jnp.stack(outconv),
               jnp.stack(outS), jnp.stack(outrS), jnp.stack(outsh))


def setup_inputs(seed: int = 0) -> dict:
    key = jax.random.key(seed)
    ks = iter(jax.random.split(key, 64))
    D = D_MODEL

    def nrm(shape, scale):
        return jax.random.normal(next(ks), shape, F32) * scale

    def uni(shape, lo, hi):
        return jax.random.uniform(next(ks), shape, F32, lo, hi)

    return {
        'x_prompt': nrm((BATCH, SEQ, D), 1.0),
        'x_sample': nrm((DEC_BATCH, DEC_SEQ, D), 1.0),
        'c_prompt': nrm((BATCH, D), 1.0),
        'c_sample': nrm((DEC_BATCH, D), 1.0),
        'state_mlstm_C': nrm((N_EVEN, DEC_BATCH, M_HEADS, M_HEAD_DIM, M_HEAD_DIM), 0.05),
        'state_mlstm_n': nrm((N_EVEN, DEC_BATCH, M_HEADS, M_HEAD_DIM), 0.5),
        'state_mlstm_m': uni((N_EVEN, DEC_BATCH, M_HEADS), 0.0, 3.0),
        'state_mlstm_conv': nrm((N_EVEN, DEC_BATCH, M_CONV - 1, 2 * M_WIDTH), 1.0),
        'state_hgrn_S': nrm((N_EVEN, DEC_BATCH, G_HEADS, G_HEAD_DIM, G_HEAD_DIM), 0.3),
        'state_rwkv_S': nrm((N_ODD, DEC_BATCH, R_HEADS, R_HEAD_DIM, R_HEAD_DIM), 0.3),
        'state_rwkv_shift': nrm((N_ODD, DEC_BATCH, D), 1.0),
        'mod_w': nrm((DEPTH, D, N_MOD * D), 0.5 * D ** -0.5),
        'mod_b': nrm((DEPTH, N_MOD * D), 0.02),
        'norm_mix': 1.0 + nrm((DEPTH, D), 0.02),
        'norm_ffn': 1.0 + nrm((DEPTH, D), 0.02),
        'ffn_w1': nrm((DEPTH, D, D_FF), D ** -0.5),
        'ffn_w2': nrm((DEPTH, D_FF, D), D_FF ** -0.5),
        'final_norm': 1.0 + nrm((D,), 0.02),
        'ab_w_in': nrm((N_EVEN, D, IN_WIDTH), D ** -0.5),
        'ab_gate_b': jnp.concatenate([uni((N_EVEN, M_HEADS), -3.0, -1.0), uni((N_EVEN, M_HEADS), 3.0, 6.0)], axis=-1),
        'm_conv_w': nrm((N_EVEN, M_CONV, 2 * M_WIDTH), M_CONV ** -0.5),
        'm_norm': 1.0 + nrm((N_EVEN, M_WIDTH), 0.02),
        'g_lb': nrm((N_EVEN + 1, G_WIDTH), 0.1) + jnp.arange(N_EVEN + 1, dtype=F32)[:, None],
        'g_norm': 1.0 + nrm((N_EVEN, G_WIDTH), 0.02),
        'ab_w_out': nrm((N_EVEN, MIX_WIDTH, D), MIX_WIDTH ** -0.5),
        'r_mu': uni((N_ODD, 6, D), 0.0, 1.0),
        'r_w0': uni((N_ODD, D), -5.0, 1.0),
        'r_w1': nrm((N_ODD, D, R_DECAY_LORA), D ** -0.5),
        'r_w2': nrm((N_ODD, R_DECAY_LORA, D), 0.5 * R_DECAY_LORA ** -0.5),
        'r_a0': nrm((N_ODD, D), 0.5),
        'r_a1': nrm((N_ODD, D, R_AAA_LORA), D ** -0.5),
        'r_a2': nrm((N_ODD, R_AAA_LORA, D), R_AAA_LORA ** -0.5),
        'r_g1': nrm((N_ODD, D, R_GATE_LORA), D ** -0.5),
        'r_g2': nrm((N_ODD, R_GATE_LORA, D), R_GATE_LORA ** -0.5),
        'r_kk': 0.85 + nrm((N_ODD, D), 0.02),
        'r_ka': 1.0 + nrm((N_ODD, D), 0.02),
        'r_rk': nrm((N_ODD, R_HEADS, R_HEAD_DIM), 0.1),
        'r_wr': nrm((N_ODD, D, D), D ** -0.5),
        'r_wk': nrm((N_ODD, D, D), D ** -0.5),
        'r_wv': nrm((N_ODD, D, D), D ** -0.5),
        'r_wo': nrm((N_ODD, D, D), D ** -0.5),
        'r_lnw': 1.0 + nrm((N_ODD, D), 0.02),
        'r_lnb': nrm((N_ODD, D), 0.02),
    }


def reference(x_prompt, x_sample, c_prompt, c_sample, state_mlstm_C, state_mlstm_n, state_mlstm_m,
              state_mlstm_conv, state_hgrn_S, state_rwkv_S, state_rwkv_shift, mod_w, mod_b, norm_mix,
              norm_ffn, ffn_w1, ffn_w2, final_norm, ab_w_in, ab_gate_b, m_conv_w, m_norm, g_lb, g_norm,
              ab_w_out, r_mu, r_w0, r_w1, r_w2, r_a0, r_a1, r_a2, r_g1, r_g2, r_kk, r_ka, r_rk, r_wr,
              r_wk, r_wv, r_wo, r_lnw, r_lnb):
    p = dict(mod_w=mod_w, mod_b=mod_b, norm_mix=norm_mix, norm_ffn=norm_ffn, ffn_w1=ffn_w1, ffn_w2=ffn_w2,
             final_norm=final_norm, ab_w_in=ab_w_in, ab_gate_b=ab_gate_b, m_conv_w=m_conv_w, m_norm=m_norm,
             g_lb=g_lb, g_norm=g_norm, ab_w_out=ab_w_out, r_mu=r_mu, r_w0=r_w0, r_w1=r_w1, r_w2=r_w2,
             r_a0=r_a0, r_a1=r_a1, r_a2=r_a2, r_g1=r_g1, r_g2=r_g2, r_kk=r_kk, r_ka=r_ka, r_rk=r_rk,
             r_wr=r_wr, r_wk=r_wk, r_wv=r_wv, r_wo=r_wo, r_lnw=r_lnw, r_lnb=r_lnb)
    B = x_prompt.shape[0]
    z_C = jnp.zeros((N_EVEN, B, M_HEADS, M_HEAD_DIM, M_HEAD_DIM), F32)
    z_n = jnp.zeros((N_EVEN, B, M_HEADS, M_HEAD_DIM), F32)
    z_m = jnp.zeros((N_EVEN, B, M_HEADS), F32)
    z_conv = jnp.zeros((N_EVEN, B, M_CONV - 1, 2 * M_WIDTH), x_prompt.dtype)
    z_S = jnp.zeros((N_EVEN, B, G_HEADS, G_HEAD_DIM, G_HEAD_DIM), F32)
    z_rS = jnp.zeros((N_ODD, B, R_HEADS, R_HEAD_DIM, R_HEAD_DIM), F32)
    z_sh = jnp.zeros((N_ODD, B, D_MODEL), x_prompt.dtype)
    y_prompt, (pC, pn, pm, pconv, pS, prS, psh) = trunk(x_prompt, c_prompt, z_C, z_n, z_m, z_conv, z_S, z_rS, z_sh, p)
    y_sample, (sC, sn, sm, sconv, sS, srS, ssh) = trunk(x_sample, c_sample, state_mlstm_C, state_mlstm_n,
                                                        state_mlstm_m, state_mlstm_conv, state_hgrn_S,
                                                        state_rwkv_S, state_rwkv_shift, p)
    return (y_prompt, y_sample, pC, pn, pm, pconv, pS, prS, psh, sC, sn, sm, sconv, sS, srS, ssh)
```

```cpp
#include <hip/hip_runtime.h>
#include <hip/hip_cooperative_groups.h>
#include <cstdio>
#include <cstdint>
namespace cg = cooperative_groups;

#ifndef USE_CG_SYNC
#define USE_CG_SYNC 0
#endif

typedef __attribute__((ext_vector_type(8))) short bf16x8;
typedef __attribute__((ext_vector_type(16))) float f32x16;
typedef __attribute__((ext_vector_type(2))) float f32x2;
typedef __attribute__((ext_vector_type(2))) __bf16 bf16x2;
typedef unsigned short u16;
__device__ __forceinline__ int TID() { int t = (int)__builtin_amdgcn_workitem_id_x(); asm volatile("" : "+v"(t)); return t; }

#define LDS_BARRIER() do { asm volatile("s_waitcnt lgkmcnt(0)" ::: "memory"); __builtin_amdgcn_s_barrier(); asm volatile("" ::: "memory"); } while (0)

constexpr int D = 2048;
constexpr int NTOK = 9216;
constexpr int NPR = 8192;
constexpr int NB = 132;
constexpr int INW = 8200;
constexpr int DFF = 8192;

enum { I_XP = 0, I_XS, I_CP, I_CS, I_MC, I_MN, I_MM, I_MCONV, I_GS, I_RS, I_RSH, I_MODW, I_MODB, I_NMIX, I_NFFN,
       I_W1, I_W2, I_FNORM, I_WIN, I_GATEB, I_CONVW, I_MNORM, I_GLB, I_GNORM, I_WOUT, I_RMU, I_RW0, I_RW1, I_RW2,
       I_RA0, I_RA1, I_RA2, I_RG1, I_RG2, I_RKK, I_RKA, I_RRK, I_WR, I_WK, I_WV, I_WO, I_LNW, I_LNB, N_IN };

constexpr size_t O_Y = 0;
constexpr size_t O_PC = 18874368;
constexpr size_t O_PN = O_PC + 1048576;
constexpr size_t O_PM = O_PN + 4096;
constexpr size_t O_PCONV = O_PM + 16;
constexpr size_t O_PS = O_PCONV + 24576;
constexpr size_t O_PRS = O_PS + 524288;
constexpr size_t O_PSH = O_PRS + 524288;
constexpr size_t O_SC = O_PSH + 8192;
constexpr size_t O_SN = O_SC + 33554432;
constexpr size_t O_SM = O_SN + 131072;
constexpr size_t O_SCONV = O_SM + 512;
constexpr size_t O_SS = O_SCONV + 786432;
constexpr size_t O_SRS = O_SS + 16777216;
constexpr size_t O_SSH = O_SRS + 16777216;

constexpr size_t W_BAR = 0;
constexpr size_t W_SCB = 65536;
constexpr size_t W_MOD = W_SCB + 256 * 2048 * 2;
constexpr size_t W_HA = W_MOD + 2ull * 132 * 12288 * 4;
constexpr size_t W_MIXED = W_HA;
constexpr size_t W_X1 = W_HA + 9216ull * 2048 * 2;
constexpr size_t W_X2 = W_X1;
constexpr size_t W_DEN = W_X1 + 9216ull * 2048 * 4;
constexpr size_t W_MST = W_DEN + 9216ull * 4 * 4;
constexpr size_t W_L1A = W_MST + 9216ull * 4 * 4;
constexpr size_t W_L1B = W_L1A + 9216ull * 128 * 2;
constexpr size_t W_L1G = W_L1B + 9216ull * 128 * 2;
constexpr size_t W_RA = W_L1G + 9216ull * 256 * 2;
constexpr size_t W_Z = W_RA;
constexpr size_t W_QK = W_Z + 9216ull * 8200 * 4;
constexpr size_t W_MO = W_QK + 9216ull * 2048 * 4;
constexpr size_t W_GO = W_MO + 9216ull * 1024 * 4;
constexpr size_t W_RA_END = W_GO + 9216ull * 1024 * 4;
constexpr size_t SZ_TOKD = 9216ull * 2048 * 4;
constexpr size_t W_R = W_RA;
constexpr size_t W_K = W_R + SZ_TOKD;
constexpr size_t W_V = W_K + SZ_TOKD;
constexpr size_t W_WP = W_V + SZ_TOKD;
constexpr size_t W_AP = W_WP + SZ_TOKD;
constexpr size_t W_G = W_AP + SZ_TOKD;
constexpr size_t W_XMIX = W_WP;
static_assert(W_G + SZ_TOKD <= W_RA_END, "region A too small");
constexpr size_t W_RB = W_RA_END;
constexpr size_t W_ACT = W_RB;
constexpr size_t W_Y = W_RB;
constexpr size_t W_WT = W_RB + 9216ull * 8192 * 2;
constexpr size_t T_WIN = 0;
constexpr size_t T_WOUT = T_WIN + 8320ull * 2048;
constexpr size_t T_W1 = T_WOUT + 2048ull * 2048;
constexpr size_t T_W2 = T_W1 + 2ull * 8192 * 2048;
constexpr size_t T_WR = T_W2 + 2ull * 8192 * 2048;
constexpr size_t T_WK = T_WR + 2048ull * 2048;
constexpr size_t T_WV = T_WK + 2048ull * 2048;
constexpr size_t T_WO = T_WV + 2048ull * 2048;
constexpr size_t T_RW1 = T_WO + 2048ull * 2048;
constexpr size_t T_RA1 = T_RW1 + 128ull * 2048;
constexpr size_t T_RG1 = T_RA1 + 128ull * 2048;
constexpr size_t T_RW2 = T_RG1 + 256ull * 2048;
constexpr size_t T_RA2 = T_RW2 + 2048ull * 128;
constexpr size_t T_RG2 = T_RA2 + 2048ull * 128;
constexpr size_t T_END = T_RG2 + 2048ull * 256;
constexpr size_t W_END = W_WT + T_END * 2;

struct Params {
  const float* in[N_IN];
  float* out;
  char* ws;
};
typedef const Params __attribute__((address_space(4)))* KP;

__device__ __forceinline__ unsigned pack2(float a, float b) {
  f32x2 v = {a, b};
  bf16x2 r = __builtin_convertvector(v, bf16x2);
  return __builtin_bit_cast(unsigned, r);
}
__device__ __forceinline__ u16 f2bf(float a) { return (u16)(pack2(a, 0.f) & 0xffffu); }
template <int CTRL> __device__ __forceinline__ float dpp_mov(float x) {
  return __int_as_float(__builtin_amdgcn_update_dpp(0, __float_as_int(x), CTRL, 0xF, 0xF, false));
}
__device__ __forceinline__ float row_sum16(float x) {
  x += dpp_mov<0x128>(x);
  x += dpp_mov<0x124>(x);
  x += dpp_mov<0x122>(x);
  x += dpp_mov<0x121>(x);
  return x;
}
__device__ __forceinline__ float wave_sum(float x) {
  x = row_sum16(x);
  x += __shfl_xor(x, 16);
  x += __shfl_xor(x, 32);
  return x;
}
__device__ __forceinline__ float sigmoidf_(float x) { return 1.f / (1.f + __expf(-x)); }
__device__ __forceinline__ float siluf_(float x) { return x / (1.f + __expf(-x)); }
__device__ __forceinline__ float logsigmoidf_(float x) { return fminf(x, 0.f) - __logf(1.f + __expf(-fabsf(x))); }

__device__ __forceinline__ void row_info(int r, int& bi, int& t, int& T) {
  if (r < NPR) { bi = r >> 11; t = r & 2047; T = 2048; }
  else { int q = r - NPR; bi = 4 + (q >> 3); t = q & 7; T = 8; }
}
__device__ __forceinline__ const float* xin_row(KP p, int r) {
  return (r < NPR) ? p->in[I_XP] + (size_t)r * D : p->in[I_XS] + (size_t)(r - NPR) * D;
}

#if USE_CG_SYNC
#define GSYNC() grid.sync()
#else
#define XB_TMO      128
#define XB_XCNT(j)  (256  + 64 * (j))
#define XB_XSUB(j)  (1280 + 64 * (j))
#define XB_XGEN(j)  (2304 + 64 * (j))
#define XB_TOP      3328
#define XB_TOPGEN   3392
#define XB_SPIN_CAP (1u << 22)
#define LAS __attribute__((address_space(3)))
__device__ __forceinline__ unsigned xb_ld(unsigned* p) { return __hip_atomic_load(p, __ATOMIC_RELAXED, __HIP_MEMORY_SCOPE_AGENT); }
__device__ __forceinline__ unsigned xb_add(unsigned* p, unsigned v) { return __hip_atomic_fetch_add(p, v, __ATOMIC_RELAXED, __HIP_MEMORY_SCOPE_AGENT); }
__device__ __forceinline__ unsigned xb_xcc_id() { return (unsigned)__builtin_amdgcn_s_getreg((3 << 11) | 20) & 0xFu; }
#define XB_SPIN(cond, bar) do { unsigned _sp = 0; while (cond) { __builtin_amdgcn_s_sleep(1); \
    if ((++_sp & 255u) == 0u) { if (xb_ld(&(bar)[XB_TMO])) break; if (_sp > XB_SPIN_CAP) { atomicAdd(&(bar)[XB_TMO], 1u); break; } } } } while (0)
struct XcdBarrier { unsigned* bar; unsigned x; volatile LAS unsigned* st; };
__device__ __forceinline__ XcdBarrier xcd_barrier_post(unsigned* bar, volatile LAS unsigned* st) {
  XcdBarrier b; b.bar = bar; b.x = xb_xcc_id(); b.st = st;
  if (TID() == 0) (void)xb_add(&bar[XB_XCNT(b.x)], 1u);
  return b;
}
__device__ __forceinline__ void xcd_barrier_complete(unsigned* bar, unsigned x, unsigned& nloc, unsigned& nx) {
  const unsigned G = gridDim.x;
  unsigned sum, cnt, mine, sp = 0u;
  for (;;) {
    sum = 0u; cnt = 0u; mine = 0u;
#pragma unroll
    for (unsigned j = 0; j < 16; ++j) { const unsigned c = xb_ld(&bar[XB_XCNT(j)]); sum += c; cnt += (c > 0u) ? 1u : 0u; mine = (j == x) ? c : mine; }
    if (sum == G) break;
    __builtin_amdgcn_s_sleep(1);
    if ((++sp & 255u) == 0u) { if (xb_ld(&bar[XB_TMO])) break; if (sp > XB_SPIN_CAP) { atomicAdd(&bar[XB_TMO], 1u); break; } }
  }
  nloc = mine > 0u ? mine : 1u; nx = cnt > 0u ? cnt : 1u;
}
__device__ __forceinline__ void xcd_barrier(const XcdBarrier& b) {
  asm volatile("s_waitcnt vmcnt(0)" ::: "memory");
  __syncthreads();
  if (TID() == 0) {
    unsigned* bar = b.bar;
    __builtin_amdgcn_s_waitcnt(0);
    unsigned nloc = b.st[0], nx = b.st[1];
    if (nloc == 0u) { xcd_barrier_complete(bar, b.x, nloc, nx); b.st[0] = nloc; b.st[1] = nx; }
    const unsigned old = xb_add(&bar[XB_XSUB(b.x)], 1u);
    const unsigned gen = old / nloc;
    if (old + 1u == (gen + 1u) * nloc) {
      __builtin_amdgcn_fence(__ATOMIC_RELEASE, "agent");
      asm volatile("s_waitcnt vmcnt(0)" ::: "memory");
      const unsigned og = xb_add(&bar[XB_TOP], 1u);
      const unsigned tg = og / nx;
      if (og + 1u == (tg + 1u) * nx) xb_add(&bar[XB_TOPGEN], 1u);
      else XB_SPIN(xb_ld(&bar[XB_TOPGEN]) == tg, bar);
      __builtin_amdgcn_fence(__ATOMIC_ACQUIRE, "agent");
      xb_add(&bar[XB_XGEN(b.x)], 1u);
      asm volatile("s_waitcnt vmcnt(0)" ::: "memory");
    } else {
      XB_SPIN(xb_ld(&bar[XB_XGEN(b.x)]) == gen, bar);
      __builtin_amdgcn_fence(__ATOMIC_ACQUIRE, "agent");
      asm volatile("s_waitcnt vmcnt(0)" ::: "memory");
    }
  }
  __syncthreads();
}
#define GSYNC() xcd_barrier(xb)
#endif

constexpr int GL_STRIDE = 80;
constexpr int GL_BUF = 256 * GL_STRIDE;
constexpr int LDS_BYTES = 65536;

#define EPI_ELEM(...) [=](int rb, int ro, int col, float v0, float v1, float v2, float v3) { \
    { const int row = rb + ro + 0; const float v = v0; __VA_ARGS__ } { const int row = rb + ro + 1; const float v = v1; __VA_ARGS__ } \
    { const int row = rb + ro + 2; const float v = v2; __VA_ARGS__ } { const int row = rb + ro + 3; const float v = v3; __VA_ARGS__ } }
#define EPI_RESID(DST, SRCEXPR, MODP, CH) [=](int rb, int ro, int col, float v0, float v1, float v2, float v3) { \
    const int bi = (rb < NPR) ? (rb >> 11) : 4 + ((rb - NPR) >> 3); \
    const float g = (MODP)[(unsigned)((bi * 6 + (CH)) * D + col)]; \
    const float* xb = SRCEXPR; \
    const unsigned o = (unsigned)(rb + ro) * D + col; \
    DST[o] = xb[o] + g * v0; DST[o + D] = xb[o + D] + g * v1; DST[o + 2 * D] = xb[o + 2 * D] + g * v2; DST[o + 3 * D] = xb[o + 3 * D] + g * v3; }
template <class Epi>
__device__ __forceinline__ void gemm_job(char* lds, const u16* __restrict__ A, int lda, const float* __restrict__ B, int ldb,
                                         int Mt, int N, int K, int rot, Epi epi) {
  const int tid = TID(), lane = tid & 63, w = tid >> 6;
  const int ntn = (N + 127) >> 7;
  const int ntiles = Mt * ntn;
  const int G = gridDim.x;
  const int start = (int)((blockIdx.x + (unsigned)G - (unsigned)(rot % G)) % (unsigned)G);
  const int ar = tid >> 2, ac = tid & 3;
  const int np = tid & 63, ko = tid >> 6;
  const int wm = w >> 1, wn = w & 1;
  const int fr = lane & 31, fh = lane >> 5;
  const int nk = K >> 5;
  for (int tile = start; tile < ntiles; tile += G) {
    const int tm = tile % Mt, tn = tile / Mt;
    const int m0 = tm * 128, n0 = tn * 128;
    f32x16 acc[2][2];
#pragma unroll
    for (int i = 0; i < 2; ++i)
#pragma unroll
      for (int j = 0; j < 2; ++j)
#pragma unroll
        for (int r = 0; r < 16; ++r) acc[i][j][r] = 0.f;
    const u16* Ap0 = A + (size_t)(m0 + ar) * lda + ac * 8;
    const u16* Ap1 = Ap0 + (size_t)64 * lda;
    const int bcol = n0 + 2 * np;
    const bool bval = bcol < N;
    const float* Bp = B + (size_t)(ko * 8) * ldb + (bval ? bcol : 0);
    uint4 ra0_0, ra1_0, ra0_1, ra1_1;
    float2 rb_0[8], rb_1[8];
#define GJ_LOAD(s, k0) { ra0_##s = *(const uint4*)(Ap0 + (k0)); ra1_##s = *(const uint4*)(Ap1 + (k0));                 \
      _Pragma("unroll") for (int j = 0; j < 8; ++j) rb_##s[j] = *(const float2*)(Bp + (size_t)((k0) + j) * ldb); }
#define GJ_WRITE(s, buf) {                                                                                             \
      *(uint4*)((buf) + ar * GL_STRIDE + ac * 16) = ra0_##s;                                                            \
      *(uint4*)((buf) + (ar + 64) * GL_STRIDE + ac * 16) = ra1_##s;                                                     \
      char* bb = (buf) + 128 * GL_STRIDE;                                                                               \
      uint4 lo, hi;                                                                                                     \
      if (bval) {                                                                                                       \
        lo.x = pack2(rb_##s[0].x, rb_##s[1].x); lo.y = pack2(rb_##s[2].x, rb_##s[3].x); lo.z = pack2(rb_##s[4].x, rb_##s[5].x); lo.w = pack2(rb_##s[6].x, rb_##s[7].x); \
        hi.x = pack2(rb_##s[0].y, rb_##s[1].y); hi.y = pack2(rb_##s[2].y, rb_##s[3].y); hi.z = pack2(rb_##s[4].y, rb_##s[5].y); hi.w = pack2(rb_##s[6].y, rb_##s[7].y); \
      } else { lo = make_uint4(0, 0, 0, 0); hi = lo; }                                                                  \
      *(uint4*)(bb + (2 * np) * GL_STRIDE + ko * 16) = lo;                                                              \
      *(uint4*)(bb + (2 * np + 1) * GL_STRIDE + ko * 16) = hi; }
#define GJ_MMA(cur) {                                                                                                  \
      _Pragma("unroll") for (int kk = 0; kk < 2; ++kk) {                                                                \
        bf16x8 a[2], b[2];                                                                                              \
        _Pragma("unroll") for (int mi = 0; mi < 2; ++mi) a[mi] = *(const bf16x8*)((cur) + (wm * 64 + mi * 32 + fr) * GL_STRIDE + kk * 32 + fh * 16); \
        _Pragma("unroll") for (int ni = 0; ni < 2; ++ni) b[ni] = *(const bf16x8*)((cur) + (128 + wn * 64 + ni * 32 + fr) * GL_STRIDE + kk * 32 + fh * 16); \
        _Pragma("unroll") for (int mi = 0; mi < 2; ++mi) _Pragma("unroll") for (int ni = 0; ni < 2; ++ni)               \
          acc[mi][ni] = __builtin_amdgcn_mfma_f32_32x32x16_bf16(a[mi], b[ni], acc[mi][ni], 0, 0, 0); } }
    char* const lds0 = lds;
    char* const lds1 = lds + GL_BUF;
    GJ_LOAD(0, 0)
    GJ_WRITE(0, lds0)
    if (nk > 1) GJ_LOAD(1, 32)
    if (nk > 2) GJ_LOAD(0, 64)
    __syncthreads();
    for (int it = 0; it < nk; it += 2) {
      GJ_MMA(lds0)
      if (it + 1 < nk) { GJ_WRITE(1, lds1) if (it + 3 < nk) GJ_LOAD(1, (it + 3) * 32) }
      LDS_BARRIER();
      GJ_MMA(lds1)
      if (it + 2 < nk) { GJ_WRITE(0, lds0) if (it + 4 < nk) GJ_LOAD(0, (it + 4) * 32) }
      LDS_BARRIER();
    }
#undef GJ_LOAD
#undef GJ_WRITE
#undef GJ_MMA
    __syncthreads();
    {
      const int wmu = __builtin_amdgcn_readfirstlane(wm), wnu = __builtin_amdgcn_readfirstlane(wn);
#pragma unroll
      for (int mi = 0; mi < 2; ++mi)
#pragma unroll
        for (int ni = 0; ni < 2; ++ni) {
          const int col = n0 + wnu * 64 + ni * 32 + fr;
          if (col < N) {
#pragma unroll
            for (int rq = 0; rq < 4; ++rq) {
              const int rbase = m0 + wmu * 64 + mi * 32 + 8 * rq;
              epi(rbase, 4 * fh, col, acc[mi][ni][rq * 4 + 0], acc[mi][ni][rq * 4 + 1], acc[mi][ni][rq * 4 + 2], acc[mi][ni][rq * 4 + 3]);
              __builtin_amdgcn_sched_barrier(0);
            }
          }
        }
    }
  }
}

__shared__ __attribute__((aligned(16))) char g_lds[LDS_BYTES + 64];

#ifndef USE_GLDS
#define USE_GLDS 0
#endif
#if USE_GLDS
#define GLDS16(gp, lp) __builtin_amdgcn_global_load_lds((const unsigned*)(gp), (unsigned*)(lp), 16, 0, 0)
#else
#define GLDS16(gp, lp) (*(uint4*)(lp) = *(const uint4*)(gp))
#endif
#define EPI_ACT_PACKED(DST) [=](int rb, int ro, int col, float v0, float v1, float v2, float v3) { \
    float a0 = fmaxf(v0, 0.f), a1 = fmaxf(v1, 0.f), a2 = fmaxf(v2, 0.f), a3 = fmaxf(v3, 0.f); \
    a0 *= a0; a1 *= a1; a2 *= a2; a3 *= a3; \
    const float x0 = dpp_mov<0xB1>(a0), x1 = dpp_mov<0xB1>(a1), x2 = dpp_mov<0xB1>(a2), x3 = dpp_mov<0xB1>(a3); \
    const bool odd = (col & 1) != 0; \
    const unsigned w0 = odd ? pack2(x2, a2) : pack2(a0, x0); \
    const unsigned w1 = odd ? pack2(x3, a3) : pack2(a1, x1); \
    const unsigned o = (unsigned)(rb + ro + (odd ? 2 : 0)) * DFF + (unsigned)(col & ~1); \
    *(unsigned*)(DST + o) = w0; *(unsigned*)(DST + o + DFF) = w1; }
#define EPI_RESID_ATOMIC(DST, MODP, CH) [=](int rb, int ro, int col, float v0, float v1, float v2, float v3) { \
    const int rr_ = rb + ro; const int bi = (rr_ < NPR) ? (rr_ >> 11) : 4 + ((rr_ - NPR) >> 3); \
    const float g = (MODP)[(unsigned)((bi * 6 + (CH)) * D + col)]; \
    const unsigned o = (unsigned)(rb + ro) * D + col; \
    unsafeAtomicAdd(&DST[o], g * v0); unsafeAtomicAdd(&DST[o + D], g * v1); unsafeAtomicAdd(&DST[o + 2 * D], g * v2); unsafeAtomicAdd(&DST[o + 3 * D], g * v3); }
template <class Epi, class Epi2>
__device__ __forceinline__ void gemm2_impl(const u16* __restrict__ A, int lda, const u16* __restrict__ Bt, int ldb,
                                           int Mt, int Nt, int N, int K, int rot, Epi epi, Epi2 epi2, bool split) {
  const int tid = TID(), lane = tid & 63, w = tid >> 6;
  const int ntiles = Mt * Nt;
  const int G = gridDim.x;
  const int start = (int)((blockIdx.x + (unsigned)G - (unsigned)(rot % G)) % (unsigned)G);
  const int wm = w >> 1, wn = w & 1;
  const int fr = lane & 31, fh = lane >> 5;
  const int nk = K >> 6;
  const int lrow = tid >> 3, lpos = tid & 7;
  const int sw = (lpos ^ ((lrow >> 1) & 7)) * 8;
  auto body = [&](int tile, int kit0, int nkp, auto&& ep) {
    const int tm = tile % Mt, tn = tile / Mt;
    const int m0 = tm * 128, n0 = tn * 128;
    f32x16 acc[2][2];
#pragma unroll
    for (int i = 0; i < 2; ++i)
#pragma unroll
      for (int j = 0; j < 2; ++j)
#pragma unroll
        for (int r = 0; r < 16; ++r) acc[i][j][r] = 0.f;
    const u16* ga = A + (size_t)(m0 + lrow) * lda + sw + kit0 * 64;
    const u16* gb = Bt + (size_t)(n0 + lrow) * ldb + sw + kit0 * 64;
    auto compute = [&](int stage) {
      const char* sA = g_lds + stage * 32768;
      const char* sB = sA + 16384;
      __builtin_amdgcn_s_setprio(1);
#pragma unroll
      for (int kk = 0; kk < 4; ++kk) {
        bf16x8 a[2], b[2];
#pragma unroll
        for (int mi = 0; mi < 2; ++mi) {
          const int r = wm * 64 + mi * 32 + fr;
          a[mi] = *(const bf16x8*)(sA + r * 128 + (((kk * 2 + fh) ^ ((r >> 1) & 7)) * 16));
        }
#pragma unroll
        for (int ni = 0; ni < 2; ++ni) {
          const int r = wn * 64 + ni * 32 + fr;
          b[ni] = *(const bf16x8*)(sB + r * 128 + (((kk * 2 + fh) ^ ((r >> 1) & 7)) * 16));
        }
#pragma unroll
        for (int mi = 0; mi < 2; ++mi)
#pragma unroll
          for (int ni = 0; ni < 2; ++ni) acc[mi][ni] = __builtin_amdgcn_mfma_f32_32x32x16_bf16(a[mi], b[ni], acc[mi][ni], 0, 0, 0);
      }
      __builtin_amdgcn_s_setprio(0);
    };
#if USE_GLDS
    auto issue = [&](int stage, int k0) {
#pragma unroll
      for (int i = 0; i < 4; ++i) GLDS16(ga + (size_t)i * 32 * lda + k0, g_lds + stage * 32768 + tid * 16 + i * 4096);
#pragma unroll
      for (int i = 0; i < 4; ++i) GLDS16(gb + (size_t)i * 32 * ldb + k0, g_lds + stage * 32768 + 16384 + tid * 16 + i * 4096);
    };
    issue(0, 0);
    for (int it = 0; it < nkp; ++it) {
      asm volatile("s_waitcnt vmcnt(0)" ::: "memory");
      __syncthreads();
      __builtin_amdgcn_s_sleep(4);
      __syncthreads();
      if (it + 1 < nkp) issue((it + 1) & 1, (it + 1) * 64);
      compute(it & 1);
    }
#else
    uint4 ra0, ra1, ra2, ra3, rb0, rb1, rb2, rb3;
    auto gload = [&](int k0) {
      ra0 = *(const uint4*)(ga + k0);
      ra1 = *(const uint4*)(ga + (size_t)32 * lda + k0);
      ra2 = *(const uint4*)(ga + (size_t)64 * lda + k0);
      ra3 = *(const uint4*)(ga + (size_t)96 * lda + k0);
      rb0 = *(const uint4*)(gb + k0);
      rb1 = *(const uint4*)(gb + (size_t)32 * ldb + k0);
      rb2 = *(const uint4*)(gb + (size_t)64 * ldb + k0);
      rb3 = *(const uint4*)(gb + (size_t)96 * ldb + k0);
    };
    auto lwrite = [&](int stage) {
      char* d = g_lds + stage * 32768 + tid * 16;
      *(uint4*)(d) = ra0; *(uint4*)(d + 4096) = ra1; *(uint4*)(d + 8192) = ra2; *(uint4*)(d + 12288) = ra3;
      *(uint4*)(d + 16384) = rb0; *(uint4*)(d + 20480) = rb1; *(uint4*)(d + 24576) = rb2; *(uint4*)(d + 28672) = rb3;
    };
    gload(0);
    lwrite(0);
    if (nkp > 1) gload(64);
    __syncthreads();
    for (int it = 0; it < nkp; ++it) {
      compute(it & 1);
      __builtin_amdgcn_sched_barrier(0);
      if (it + 1 < nkp) {
        lwrite((it + 1) & 1);
        __builtin_amdgcn_sched_barrier(0);
        if (it + 2 < nkp) gload((it + 2) * 64);
      }
      LDS_BARRIER();
    }
#endif
    __syncthreads();
    {
      const int wmu = __builtin_amdgcn_readfirstlane(wm), wnu = __builtin_amdgcn_readfirstlane(wn);
#pragma unroll
      for (int mi = 0; mi < 2; ++mi)
#pragma unroll
        for (int ni = 0; ni < 2; ++ni) {
          const int col = n0 + wnu * 64 + ni * 32 + fr;
          if (col < N) {
#pragma unroll
            for (int rq = 0; rq < 4; ++rq) {
              const int rbase = m0 + wmu * 64 + mi * 32 + 8 * rq;
              ep(rbase, 4 * fh, col, acc[mi][ni][rq * 4 + 0], acc[mi][ni][rq * 4 + 1], acc[mi][ni][rq * 4 + 2], acc[mi][ni][rq * 4 + 3]);
              __builtin_amdgcn_sched_barrier(0);
            }
          }
        }
    }
  };
  int main_tiles = ntiles, tail = 0;
  if (split) {
    const int full = ntiles / G;
    tail = ntiles - full * G;
    if (tail > 0 && tail * 4 <= G && (nk & 3) == 0) main_tiles = full * G; else tail = 0;
  }
  for (int tile = start; tile < main_tiles; tile += G) body(tile, 0, nk, epi);
  if (tail > 0 && (int)blockIdx.x < tail * 4) {
    const int wq = (int)blockIdx.x / tail, wt = (int)blockIdx.x - wq * tail;
    body(main_tiles + wt, wq * (nk >> 2), nk >> 2, epi2);
  }
}
template <class Epi>
__device__ __forceinline__ void gemm2_job(const u16* __restrict__ A, int lda, const u16* __restrict__ Bt, int ldb,
                                          int Mt, int Nt, int N, int K, int rot, Epi epi) {
  gemm2_impl(A, lda, Bt, ldb, Mt, Nt, N, K, rot, epi, epi, false);
}

__device__ __forceinline__ void transpose_job(const float* __restrict__ src, int K, int N, u16* __restrict__ dst, int Kpad, int Npad, int rot,
                                              int nb = 0, int bid = 0) {
  float* tl = (float*)g_lds;
  const int tid = TID();
  const int tk_n = Kpad >> 6, ntiles = tk_n * (Npad >> 6);
  const int G = nb ? nb : (int)gridDim.x;
  const int bx = nb ? bid : (int)blockIdx.x;
  const int start = (int)(((unsigned)bx + (unsigned)G - (unsigned)(rot % G)) % (unsigned)G);
  for (int tile = start; tile < ntiles; tile += G) {
    const int k0 = (tile % tk_n) * 64, n0 = (tile / tk_n) * 64;
    __syncthreads();
#pragma unroll
    for (int i = 0; i < 4; ++i) {
      const int kk = (tid >> 4) + 16 * i, n4 = (tid & 15) * 4;
      float4 v = make_float4(0, 0, 0, 0);
      if (k0 + kk < K && n0 + n4 < N) v = *(const float4*)(src + (size_t)(k0 + kk) * N + n0 + n4);
      float* d = tl + kk * 65 + n4;
      d[0] = v.x; d[1] = v.y; d[2] = v.z; d[3] = v.w;
    }
    __syncthreads();
#pragma unroll
    for (int i = 0; i < 2; ++i) {
      const int n = (tid >> 3) + 32 * i, c = tid & 7;
      const float* s = tl + (c * 8) * 65 + n;
      uint4 o;
      o.x = pack2(s[0], s[65]); o.y = pack2(s[130], s[195]); o.z = pack2(s[260], s[325]); o.w = pack2(s[390], s[455]);
      *(uint4*)(dst + (size_t)(n0 + n) * Kpad + k0 + c * 8) = o;
    }
  }
}

__device__ __forceinline__ float block_sum(float v, float* red) {
  v = wave_sum(v);
  __syncthreads();
  if ((TID() & 63) == 0) red[TID() >> 6] = v;
  __syncthreads();
  return red[0] + red[1] + red[2] + red[3];
}
template <int MODE, class XRow>
__device__ __forceinline__ void norm_pass(KP p, float* red_unused, XRow xrow, const float* __restrict__ gam, int layer, int modbase) {
  constexpr int NR = (MODE == 1) ? 9 : 8;
  constexpr int R0 = (MODE == 1) ? -1 : 0;
  const int tid = TID(), lane = tid & 63, w = tid >> 6;
  float* red = (float*)g_lds;
  const float* MOD = (const float*)(p->ws + W_MOD) + (size_t)layer * NB * 12288;
  u16* HA = (u16*)(p->ws + W_HA);
  u16* XM = (u16*)(p->ws + W_XMIX);
  for (int task = blockIdx.x; task < NTOK / 8; task += gridDim.x) {
    const int rb = task * 8;
    int bi, t0, T;
    row_info(rb, bi, t0, T);
    const float* sh = MOD + ((size_t)bi * 6 + modbase) * D;
    const float* sc = sh + D;
    float4 x[NR][2];
    float ss[NR];
#pragma unroll
    for (int i = 0; i < NR; ++i) {
      int r = rb + R0 + i;
      if (MODE == 1 && i == 0 && t0 == 0) r = rb;
      const float* xr = xrow(r);
      x[i][0] = *(const float4*)(xr + tid * 4);
      x[i][1] = *(const float4*)(xr + 1024 + tid * 4);
    }
#pragma unroll
    for (int i = 0; i < NR; ++i) {
      ss[i] = x[i][0].x * x[i][0].x + x[i][0].y * x[i][0].y + x[i][0].z * x[i][0].z + x[i][0].w * x[i][0].w +
              x[i][1].x * x[i][1].x + x[i][1].y * x[i][1].y + x[i][1].z * x[i][1].z + x[i][1].w * x[i][1].w;
      ss[i] = wave_sum(ss[i]);
    }
    __syncthreads();
    if (lane == 0) {
#pragma unroll
      for (int i = 0; i < NR; ++i) red[w * NR + i] = ss[i];
    }
    __syncthreads();
#pragma unroll
    for (int j = 0; j < 2; ++j) {
      const int c = j * 1024 + tid * 4;
      const float4 g = *(const float4*)(gam + c);
      float4 a = make_float4(0, 0, 0, 0), b = a;
      if (MODE != 2) { a = *(const float4*)(sc + c); b = *(const float4*)(sh + c); }
#pragma unroll
      for (int i = 0; i < NR; ++i) {
        const float rstd = rsqrtf((red[i] + red[NR + i] + red[2 * NR + i] + red[3 * NR + i]) * (1.f / D) + 1e-6f);
        float4 h;
        h.x = x[i][j].x * rstd * g.x; h.y = x[i][j].y * rstd * g.y; h.z = x[i][j].z * rstd * g.z; h.w = x[i][j].w * rstd * g.w;
        if (MODE != 2) { h.x = h.x * (1.f + a.x) + b.x; h.y = h.y * (1.f + a.y) + b.y; h.z = h.z * (1.f + a.z) + b.z; h.w = h.w * (1.f + a.w) + b.w; }
        x[i][j] = h;
        const int r = rb + R0 + i;
        if (MODE == 0) {
          uint2 o; o.x = pack2(h.x, h.y); o.y = pack2(h.z, h.w);
          *(uint2*)(HA + (size_t)r * D + c) = o;
        } else if (MODE == 2) {
          *(float4*)(p->out + O_Y + (size_t)r * D + c) = h;
        }
      }
      if (MODE == 1) {
        float4 pv = x[0][j];
        if (t0 == 0) pv = (bi >= 4) ? *(const float4*)(p->in[I_RSH] + (size_t)(bi - 4) * D + c) : make_float4(0, 0, 0, 0);
#pragma unroll
        for (int i = 1; i < NR; ++i) {
          const int r = rb + i - 1;
          const float4 h = x[i][j];
#pragma unroll 1
          for (int q = 0; q < 6; ++q) {
            const float4 mu = *(const float4*)(p->in[I_RMU] + (size_t)q * D + c);
            uint2 o;
            o.x = pack2(h.x + (pv.x - h.x) * mu.x, h.y + (pv.y - h.y) * mu.y);
            o.y = pack2(h.z + (pv.z - h.z) * mu.z, h.w + (pv.w - h.w) * mu.w);
            *(uint2*)(XM + ((size_t)q * NTOK + r) * D + c) = o;
          }
          if (t0 + i - 1 == T - 1) {
            float* so = (bi < 4) ? p->out + O_PSH + (size_t)bi * D : p->out + O_SSH + (size_t)(bi - 4) * D;
            *(float4*)(so + c) = h;
          }
          pv = h;
        }
      }
    }
  }
}

__device__ __forceinline__ int next_unit(unsigned* ctr, int* s_unit) {
  __syncthreads();
  if (TID() == 0) *s_unit = (int)atomicAdd(ctr, 1u);
  __syncthreads();
  return *s_unit;
}
__device__ __forceinline__ int publish_unit(int nxt, int* s_unit) {
  __syncthreads();
  if (TID() == 0) *s_unit = nxt;
  __syncthreads();
  return *s_unit;
}


__device__ __forceinline__ float fma_(float a, float b, float c) { float d; asm("v_fma_f32 %0, %1, %2, %3" : "=v"(d) : "v"(a), "v"(b), "v"(c)); return d; }
__device__ __forceinline__ float mul_(float a, float b) { float d; asm("v_mul_f32 %0, %1, %2" : "=v"(d) : "v"(a), "v"(b)); return d; }
__device__ __forceinline__ float sub_(float a, float b) { float d; asm("v_sub_f32 %0, %1, %2" : "=v"(d) : "v"(a), "v"(b)); return d; }
__device__ __forceinline__ float row_sum16_asm(float x) { asm volatile("s_nop 1"); return row_sum16(x + 0.f * x); }
#define ML_LD(S, t)                                                                                                   \
  S##q0 = *(const float4*)(in + (t) * 256 + 0 * 64 + l16 * 4); S##k0 = *(const float4*)(in + TC * 256 + (t) * 256 + 0 * 64 + l16 * 4); \
  S##q1 = *(const float4*)(in + (t) * 256 + 1 * 64 + l16 * 4); S##k1 = *(const float4*)(in + TC * 256 + (t) * 256 + 1 * 64 + l16 * 4); \
  S##q2 = *(const float4*)(in + (t) * 256 + 2 * 64 + l16 * 4); S##k2 = *(const float4*)(in + TC * 256 + (t) * 256 + 2 * 64 + l16 * 4); \
  S##q3 = *(const float4*)(in + (t) * 256 + 3 * 64 + l16 * 4); S##k3 = *(const float4*)(in + TC * 256 + (t) * 256 + 3 * 64 + l16 * 4); \
  S##fp = sfp[t]; S##iv = sip[t] * in[TC * 512 + (t) * 16 + grp];
#define ML_M(S, jj, e, x) tt_[jj * 4 + e] = mul_(S##k##jj.x, S##iv);
#define ML_U(S, jj, e, x) C[jj * 4 + e] = fma_(S##fp, C[jj * 4 + e], tt_[jj * 4 + e]);
#define ML_A(S, jj, e, x) acc##e = fma_(S##q##jj.x, C[jj * 4 + e], acc##e);
#define ML_ALL(OP, S) OP(S, 0, 0, x) OP(S, 0, 1, y) OP(S, 0, 2, z) OP(S, 0, 3, w) OP(S, 1, 0, x) OP(S, 1, 1, y) OP(S, 1, 2, z) OP(S, 1, 3, w) \
                      OP(S, 2, 0, x) OP(S, 2, 1, y) OP(S, 2, 2, z) OP(S, 2, 3, w) OP(S, 3, 0, x) OP(S, 3, 1, y) OP(S, 3, 2, z) OP(S, 3, 3, w)
#define ML_CP(S, t) { float tt_[16]; float acc0 = 0.f, acc1 = 0.f, acc2 = 0.f, acc3 = 0.f; ML_ALL(ML_M, S) ML_ALL(ML_U, S) ML_ALL(ML_A, S) \
  float acc = row_sum16_asm((acc0 + acc1) + (acc2 + acc3)); if (l16 == 0) so[b * TC * 16 + (t) * 16 + grp] = acc; }

#define HG_LD(S, t)                                                                                                   \
  S##q0 = *(const float4*)(in + (t) * 128 + l16 * 4); S##q1 = *(const float4*)(in + (t) * 128 + 64 + l16 * 4);         \
  S##f0 = *(const float4*)(in + TC * 128 + (t) * 128 + l16 * 4); S##f1 = *(const float4*)(in + TC * 128 + (t) * 128 + 64 + l16 * 4); \
  S##va = in[TC * 256 + (t) * 32 + grp]; S##vb = in[TC * 256 + (t) * 32 + 16 + grp];
#define HG_D(S, jj, e, x) d0_[jj * 4 + e] = sub_(S0[jj * 4 + e], S##va); d1_[jj * 4 + e] = sub_(S1[jj * 4 + e], S##vb);
#define HG_U(S, jj, e, x) S0[jj * 4 + e] = fma_(S##f##jj.x, d0_[jj * 4 + e], S##va); S1[jj * 4 + e] = fma_(S##f##jj.x, d1_[jj * 4 + e], S##vb);
#define HG_A(S, jj, e, x) a0##e = fma_(S##q##jj.x, S0[jj * 4 + e], a0##e); a1##e = fma_(S##q##jj.x, S1[jj * 4 + e], a1##e);
#define HG_ALL(OP, S) OP(S, 0, 0, x) OP(S, 0, 1, y) OP(S, 0, 2, z) OP(S, 0, 3, w) OP(S, 1, 0, x) OP(S, 1, 1, y) OP(S, 1, 2, z) OP(S, 1, 3, w)
#define HG_CP(S, t) { float d0_[8], d1_[8]; float a00 = 0.f, a01 = 0.f, a02 = 0.f, a03 = 0.f, a10 = 0.f, a11 = 0.f, a12 = 0.f, a13 = 0.f; \
  HG_ALL(HG_D, S) HG_ALL(HG_U, S) HG_ALL(HG_A, S)                                                                       \
  float acc0 = row_sum16_asm((a00 + a01) + (a02 + a03)); float acc1 = row_sum16_asm((a10 + a11) + (a12 + a13));        \
  if (l16 == 0) { so[b * TC * 32 + (t) * 32 + grp] = acc0; so[b * TC * 32 + (t) * 32 + 16 + grp] = acc1; } }

#define RW_LD(S, t)                                                                                                   \
  S##w = *(const float4*)(in + (t) * 64 + l16 * 4); S##a = *(const float4*)(in + TC * 64 + (t) * 64 + l16 * 4);        \
  S##b = *(const float4*)(in + TC * 128 + (t) * 64 + l16 * 4); S##k = *(const float4*)(in + TC * 192 + (t) * 64 + l16 * 4); \
  S##r = *(const float4*)(in + TC * 256 + (t) * 64 + l16 * 4);                                                         \
  S##va = in[TC * 320 + (t) * 32 + grp]; S##vb = in[TC * 320 + (t) * 32 + 16 + grp];
#define RW_UP(X, sa, vv, S, c) X.c = fma_(X.c, S##w.c, fma_(sa, S##b.c, mul_(vv, S##k.c)));
#define RW_DOT2(r0_, r1_, V) { float p0 = mul_(S0.x, V.x), p1 = mul_(S1.x, V.x), p2 = mul_(S0.y, V.y), p3 = mul_(S1.y, V.y);       \
    p0 = fma_(S0.z, V.z, p0); p1 = fma_(S1.z, V.z, p1); p2 = fma_(S0.w, V.w, p2); p3 = fma_(S1.w, V.w, p3); r0_ = p0 + p2; r1_ = p1 + p3; }
#define RW_CP(S, t) {                                                                                                 \
  float sa0, sa1; RW_DOT2(sa0, sa1, S##a)                                                                              \
  sa0 = row_sum16_asm(sa0); sa1 = row_sum16_asm(sa1);                                                                 \
  RW_UP(S0, sa0, S##va, S, x) RW_UP(S1, sa1, S##vb, S, x) RW_UP(S0, sa0, S##va, S, y) RW_UP(S1, sa1, S##vb, S, y)      \
  RW_UP(S0, sa0, S##va, S, z) RW_UP(S1, sa1, S##vb, S, z) RW_UP(S0, sa0, S##va, S, w) RW_UP(S1, sa1, S##vb, S, w)      \
  float y0, y1; RW_DOT2(y0, y1, S##r)                                                                                  \
  y0 = row_sum16_asm(y0); y1 = row_sum16_asm(y1);                                                                     \
  if (l16 == 0) { so[b * TC * 32 + (t) * 32 + grp] = y0; so[b * TC * 32 + (t) * 32 + 16 + grp] = y1; } }

template <bool PROMPT>
__device__ __forceinline__ void mlstm_unit(KP p, float* lds, int bi, int h, int eg) {
  constexpr int TC = 8;
  constexpr int NCH = PROMPT ? 256 : 1;
  constexpr int INSZ = TC * 512 + TC * 16 + 32;
  const int tid = TID(), l16 = tid & 15, grp = tid >> 4;
  const int r0 = PROMPT ? bi * 2048 : NPR + (bi - 4) * 8;
  const float* Z = (const float*)(p->ws + W_Z);
  const float* QK = (const float*)(p->ws + W_QK);
  float* MO = (float*)(p->ws + W_MO);
  float* DEN = (float*)(p->ws + W_DEN);
  float* MST = (float*)(p->ws + W_MST);
  float* so = lds + 2 * INSZ;
  float* sfp = so + 2 * TC * 16;
  float* sip = sfp + 16;
  float* smp = sip + 16;
  float* smc = smp + 32;
  float C[16];
  const int e = eg * 16 + grp;
  if (!PROMPT) {
    const int bs = bi - 4;
    if (eg < 16) {
      const float* base = p->in[I_MC] + ((size_t)(bs * 4 + h) * 256) * 256 + eg * 16;
      float* st = lds + 9000;
      float4 sv4[4];
#pragma unroll
      for (int i = 0; i < 4; ++i) sv4[i] = *(const float4*)(base + (size_t)((tid >> 2) + 64 * i) * 256 + (tid & 3) * 4);
#pragma unroll
      for (int i = 0; i < 4; ++i) {
        float* d = st + ((tid >> 2) + 64 * i) * 17 + (tid & 3) * 4;
        d[0] = sv4[i].x; d[1] = sv4[i].y; d[2] = sv4[i].z; d[3] = sv4[i].w;
      }
      __syncthreads();
#pragma unroll
      for (int jj = 0; jj < 4; ++jj)
#pragma unroll
        for (int j4 = 0; j4 < 4; ++j4) C[jj * 4 + j4] = st[(jj * 64 + l16 * 4 + j4) * 17 + grp];
    } else {
      const float* base = p->in[I_MN] + (size_t)(bs * 4 + h) * 256;
#pragma unroll
      for (int jj = 0; jj < 4; ++jj)
#pragma unroll
        for (int j4 = 0; j4 < 4; ++j4) C[jj * 4 + j4] = (grp == 0) ? base[jj * 64 + l16 * 4 + j4] : 0.f;
    }
    if (tid == 0) smc[0] = p->in[I_MM][bs * 4 + h];
  } else {
#pragma unroll
    for (int i = 0; i < 16; ++i) C[i] = 0.f;
    if (tid == 0) smc[0] = 0.f;
  }
  const float gbi = p->in[I_GATEB][h], gbf = p->in[I_GATEB][4 + h];
  constexpr int KD = PROMPT ? 4 : 1;
  float4 pq0_0, pq0_1, pq0_2, pq0_3, pq1_0, pq1_1, pq1_2, pq1_3, pk0_0, pk0_1, pk0_2, pk0_3, pk1_0, pk1_1, pk1_2, pk1_3;
  float pv_0, pv_1, pv_2, pv_3, pgi_0, pgi_1, pgi_2, pgi_3, pgf_0, pgf_1, pgf_2, pgf_3;
#define ML_GLOAD(j, c)                                                                                               \
  {                                                                                                                  \
    const int rowb = r0 + (c) * TC;                                                                                  \
    { const int idx = tid; const float* src = QK + (size_t)(rowb + (idx >> 6)) * D + h * 256 + (idx & 63) * 4;       \
      pq0_##j = *(const float4*)src; pk0_##j = *(const float4*)(src + 1024); }                                         \
    { const int idx = tid + 256; const float* src = QK + (size_t)(rowb + (idx >> 6)) * D + h * 256 + (idx & 63) * 4; \
      pq1_##j = *(const float4*)src; pk1_##j = *(const float4*)(src + 1024); }                                         \
    pv_##j = 0.f; pgi_##j = 0.f; pgf_##j = 0.f;                                                                         \
    if (tid < TC * 16) {                                                                                             \
      const int t = tid >> 4, ee = tid & 15;                                                                         \
      pv_##j = (eg < 16) ? Z[(size_t)(rowb + t) * INW + 2048 + h * 256 + eg * 16 + ee] : (ee == 0 ? 1.f : 0.f);       \
    }                                                                                                                \
    if (tid < TC) { const float* zr = Z + (size_t)(rowb + tid) * INW; pgi_##j = zr[4096 + h]; pgf_##j = zr[4100 + h]; } \
  }
  ML_GLOAD(0, 0);
  if constexpr (KD > 1) { ML_GLOAD(1, 1); ML_GLOAD(2, 2); ML_GLOAD(3, 3); }
#define ML_BODY(j) { \
    const int c = c0 + j; \
    const int b = j & 1; \
    float* in = lds + b * INSZ; \
    *(float4*)(in + tid * 4) = pq0_##j; \
    *(float4*)(in + (tid + 256) * 4) = pq1_##j; \
    *(float4*)(in + TC * 256 + tid * 4) = pk0_##j; \
    *(float4*)(in + TC * 256 + (tid + 256) * 4) = pk1_##j; \
    if (tid < TC * 16) in[TC * 512 + tid] = pv_##j; \
    if (tid < TC) { in[TC * 528 + tid] = pgi_##j + gbi; in[TC * 528 + 16 + tid] = logsigmoidf_(pgf_##j + gbf); } \
    LDS_BARRIER(); \
    if (c + KD < NCH) ML_GLOAD(j, c + KD); \
    if (tid < 16) { \
      const int t = tid; \
      float a = 0.f, bb = -1e30f; \
      if (t < TC) { bb = in[TC * 528 + t]; a = in[TC * 528 + 16 + t]; } \
      float A = a, B = bb; \
      { const float A2 = dpp_mov<0x111>(A), B2 = dpp_mov<0x111>(B); if (t >= 1) { B = fmaxf(B2 + A, B); A = A2 + A; } } \
      { const float A2 = dpp_mov<0x112>(A), B2 = dpp_mov<0x112>(B); if (t >= 2) { B = fmaxf(B2 + A, B); A = A2 + A; } } \
      { const float A2 = dpp_mov<0x114>(A), B2 = dpp_mov<0x114>(B); if (t >= 4) { B = fmaxf(B2 + A, B); A = A2 + A; } } \
      const float mm = smc[0]; \
      const float mt = fmaxf(mm + A, B); \
      float mprev = dpp_mov<0x111>(mt); \
      if (t == 0) mprev = mm; \
      sfp[t] = __expf(a + mprev - mt); \
      sip[t] = __expf(bb - mt); \
      smp[b * 16 + t] = mt; \
      if (t == TC - 1) smc[0] = mt; \
    } \
    if (c > 0) { \
      const int pb = b ^ 1, rowb = r0 + (c - 1) * TC; \
      if (eg < 16) { \
        if (tid < TC * 16) MO[(size_t)(rowb + (tid >> 4)) * 1024 + h * 256 + eg * 16 + (tid & 15)] = so[pb * TC * 16 + tid]; \
      } else if (tid < TC) { \
        DEN[(size_t)(rowb + tid) * 4 + h] = so[pb * TC * 16 + tid * 16]; \
        MST[(size_t)(rowb + tid) * 4 + h] = smp[pb * 16 + tid]; \
      } \
    } \
    LDS_BARRIER(); \
    { float4 Aq0, Aq1, Aq2, Aq3, Ak0, Ak1, Ak2, Ak3, Bq0, Bq1, Bq2, Bq3, Bk0, Bk1, Bk2, Bk3; float Afp, Aiv, Bfp, Biv; \
    ML_LD(A, 0) \
    ML_LD(B, 1) \
    ML_CP(A, 0) \
    ML_LD(A, 2) \
    ML_CP(B, 1) \
    ML_LD(B, 3) \
    ML_CP(A, 2) \
    ML_LD(A, 4) \
    ML_CP(B, 3) \
    ML_LD(B, 5) \
    ML_CP(A, 4) \
    ML_LD(A, 6) \
    ML_CP(B, 5) \
    ML_LD(B, 7) \
    ML_CP(A, 6) \
    ML_CP(B, 7) \
    } \
  }
#pragma unroll 1
  for (int c0 = 0; c0 < NCH; c0 += KD) {
    ML_BODY(0)
    if constexpr (KD > 1) { ML_BODY(1) ML_BODY(2) ML_BODY(3) }
  }
#undef ML_BODY
#undef ML_GLOAD
  __syncthreads();
  {
    const int pb = (NCH - 1) & 1, rowb = r0 + (NCH - 1) * TC;
    if (eg < 16) {
      if (tid < TC * 16) MO[(size_t)(rowb + (tid >> 4)) * 1024 + h * 256 + eg * 16 + (tid & 15)] = so[pb * TC * 16 + tid];
    } else if (tid < TC) {
      DEN[(size_t)(rowb + tid) * 4 + h] = so[pb * TC * 16 + tid * 16];
      MST[(size_t)(rowb + tid) * 4 + h] = smp[pb * 16 + tid];
    }
  }
  if (eg < 16) {
    float* ob = PROMPT ? p->out + O_PC + ((size_t)(bi * 4 + h) * 256) * 256 + eg * 16 : p->out + O_SC + ((size_t)((bi - 4) * 4 + h) * 256) * 256 + eg * 16;
    float* st = lds + 9000;
#pragma unroll
    for (int jj = 0; jj < 4; ++jj)
#pragma unroll
      for (int j4 = 0; j4 < 4; ++j4) st[(jj * 64 + l16 * 4 + j4) * 17 + grp] = C[jj * 4 + j4];
    __syncthreads();
#pragma unroll
    for (int i = 0; i < 4; ++i) {
      const float* d = st + ((tid >> 2) + 64 * i) * 17 + (tid & 3) * 4;
      *(float4*)(ob + (size_t)((tid >> 2) + 64 * i) * 256 + (tid & 3) * 4) = make_float4(d[0], d[1], d[2], d[3]);
    }
  } else {
    if (grp == 0) {
      float* ob = PROMPT ? p->out + O_PN + (size_t)(bi * 4 + h) * 256 : p->out + O_SN + (size_t)((bi - 4) * 4 + h) * 256;
#pragma unroll
      for (int jj = 0; jj < 4; ++jj)
#pragma unroll
        for (int j4 = 0; j4 < 4; ++j4) ob[jj * 64 + l16 * 4 + j4] = C[jj * 4 + j4];
    }
    if (tid == 0) {
      float* om = PROMPT ? p->out + O_PM + bi * 4 + h : p->out + O_SM + (bi - 4) * 4 + h;
      *om = smc[0];
    }
  }
}

template <bool PROMPT>
__device__ __forceinline__ void hgrn_unit(KP p, float* lds, int bi, int g, int vg) {
  constexpr int TC = PROMPT ? 16 : 8;
  constexpr int NCH = PROMPT ? 128 : 1;
  constexpr int NL = TC / 8;
  constexpr int INSZ = TC * 256 + TC * 32;
  const int tid = TID(), l16 = tid & 15, grp = tid >> 4;
  const int r0 = PROMPT ? bi * 2048 : NPR + (bi - 4) * 8;
  const float* Z = (const float*)(p->ws + W_Z);
  float* GO = (float*)(p->ws + W_GO);
  float* so = lds + 2 * INSZ;
  float S0[8], S1[8];
  const int v0 = vg * 32 + grp;
  if (!PROMPT) {
    const float* base = p->in[I_GS] + ((size_t)((bi - 4) * 8 + g) * 128) * 128 + vg * 32;
    float* st = lds + 5200;
    float4 sv4[4];
#pragma unroll
    for (int i = 0; i < 4; ++i) sv4[i] = *(const float4*)(base + (size_t)((tid >> 3) + 32 * i) * 128 + (tid & 7) * 4);
#pragma unroll
    for (int i = 0; i < 4; ++i) {
      float* d = st + ((tid >> 3) + 32 * i) * 33 + (tid & 7) * 4;
      d[0] = sv4[i].x; d[1] = sv4[i].y; d[2] = sv4[i].z; d[3] = sv4[i].w;
    }
    __syncthreads();
#pragma unroll
    for (int jj = 0; jj < 2; ++jj)
#pragma unroll
      for (int j4 = 0; j4 < 4; ++j4) {
        S0[jj * 4 + j4] = st[(jj * 64 + l16 * 4 + j4) * 33 + grp];
        S1[jj * 4 + j4] = st[(jj * 64 + l16 * 4 + j4) * 33 + grp + 16];
      }
  } else {
#pragma unroll
    for (int i = 0; i < 8; ++i) { S0[i] = 0.f; S1[i] = 0.f; }
  }
  float4 lb4;
  {
    const int cc = g * 128 + (tid & 31) * 4;
    const float4 l0 = *(const float4*)(p->in[I_GLB] + cc);
    const float4 l1 = *(const float4*)(p->in[I_GLB] + 1024 + cc);
    lb4.x = 1.f / (1.f + __expf(l1.x - l0.x)); lb4.y = 1.f / (1.f + __expf(l1.y - l0.y));
    lb4.z = 1.f / (1.f + __expf(l1.z - l0.z)); lb4.w = 1.f / (1.f + __expf(l1.w - l0.w));
  }
  constexpr int KD = PROMPT ? 4 : 1;
  float4 pgqa_0, pgqa_1, pgqa_2, pgqa_3, pgqb_0, pgqb_1, pgqb_2, pgqb_3, pgfa_0, pgfa_1, pgfa_2, pgfa_3, pgfb_0, pgfb_1, pgfb_2, pgfb_3;
  float pva_0 = 0.f, pva_1 = 0.f, pva_2 = 0.f, pva_3 = 0.f, pvb_0 = 0.f, pvb_1 = 0.f, pvb_2 = 0.f, pvb_3 = 0.f;
  pgqb_0 = pgqb_1 = pgqb_2 = pgqb_3 = pgfb_0 = pgfb_1 = pgfb_2 = pgfb_3 = make_float4(0, 0, 0, 0);
#define HG_GLOAD(j, c)                                                                                               \
  {                                                                                                                  \
    const int rowb = r0 + (c) * TC;                                                                                  \
    { const int idx = tid;                                                                                           \
      const float* zr = Z + (size_t)(rowb + (idx >> 5)) * INW + g * 128 + (idx & 31) * 4;                            \
      pgqa_##j = *(const float4*)(zr + 4104); pgfa_##j = *(const float4*)(zr + 5128);                                \
      pva_##j = Z[(size_t)(rowb + (idx >> 5)) * INW + 6152 + g * 128 + vg * 32 + (idx & 31)]; }                      \
    if (NL > 1) { const int idx = tid + 256;                                                                         \
      const float* zr = Z + (size_t)(rowb + (idx >> 5)) * INW + g * 128 + (idx & 31) * 4;                            \
      pgqb_##j = *(const float4*)(zr + 4104); pgfb_##j = *(const float4*)(zr + 5128);                                \
      pvb_##j = Z[(size_t)(rowb + (idx >> 5)) * INW + 6152 + g * 128 + vg * 32 + (idx & 31)]; }                      \
  }
  HG_GLOAD(0, 0);
  if constexpr (KD > 1) { HG_GLOAD(1, 1); HG_GLOAD(2, 2); HG_GLOAD(3, 3); }
#define HG_BODY(j) { \
    const int c = c0 + j; \
    const int b = j & 1; \
    float* in = lds + b * INSZ; \
    const float sc = 0.08838834764831845f; \
    { const int idx = tid; float4 q, f; \
      q.x = siluf_(pgqa_##j.x) * sc; q.y = siluf_(pgqa_##j.y) * sc; q.z = siluf_(pgqa_##j.z) * sc; q.w = siluf_(pgqa_##j.w) * sc; \
      f.x = lb4.x + (1.f - lb4.x) * sigmoidf_(pgfa_##j.x); f.y = lb4.y + (1.f - lb4.y) * sigmoidf_(pgfa_##j.y); \
      f.z = lb4.z + (1.f - lb4.z) * sigmoidf_(pgfa_##j.z); f.w = lb4.w + (1.f - lb4.w) * sigmoidf_(pgfa_##j.w); \
      *(float4*)(in + idx * 4) = q; *(float4*)(in + TC * 128 + idx * 4) = f; in[TC * 256 + idx] = pva_##j; } \
    if (NL > 1) { const int idx = tid + 256; float4 q, f; \
      q.x = siluf_(pgqb_##j.x) * sc; q.y = siluf_(pgqb_##j.y) * sc; q.z = siluf_(pgqb_##j.z) * sc; q.w = siluf_(pgqb_##j.w) * sc; \
      f.x = lb4.x + (1.f - lb4.x) * sigmoidf_(pgfb_##j.x); f.y = lb4.y + (1.f - lb4.y) * sigmoidf_(pgfb_##j.y); \
      f.z = lb4.z + (1.f - lb4.z) * sigmoidf_(pgfb_##j.z); f.w = lb4.w + (1.f - lb4.w) * sigmoidf_(pgfb_##j.w); \
      *(float4*)(in + idx * 4) = q; *(float4*)(in + TC * 128 + idx * 4) = f; in[TC * 256 + idx] = pvb_##j; } \
    LDS_BARRIER(); \
    if (c + KD < NCH) HG_GLOAD(j, c + KD); \
    if (c > 0) { \
      const int pb = b ^ 1, rowb = r0 + (c - 1) * TC; \
_Pragma("unroll") \
      for (int i = 0; i < NL; ++i) { \
        const int idx = tid + 256 * i; \
        GO[(size_t)(rowb + (idx >> 5)) * 1024 + g * 128 + vg * 32 + (idx & 31)] = so[pb * TC * 32 + idx]; \
      } \
    } \
    { float4 Aq0, Aq1, Af0, Af1, Bq0, Bq1, Bf0, Bf1; float Ava, Avb, Bva, Bvb; \
    HG_LD(A, 0) \
    HG_LD(B, 1) \
    HG_CP(A, 0) \
    HG_LD(A, 2) \
    HG_CP(B, 1) \
    HG_LD(B, 3) \
    HG_CP(A, 2) \
    HG_LD(A, 4) \
    HG_CP(B, 3) \
    HG_LD(B, 5) \
    HG_CP(A, 4) \
    HG_LD(A, 6) \
    HG_CP(B, 5) \
    HG_LD(B, 7) \
    HG_CP(A, 6) \
    if constexpr (TC == 16) { HG_LD(A, 8) } \
    HG_CP(B, 7) \
    if constexpr (TC == 16) { \
    HG_LD(B, 9) \
    HG_CP(A, 8) \
    HG_LD(A, 10) \
    HG_CP(B, 9) \
    HG_LD(B, 11) \
    HG_CP(A, 10) \
    HG_LD(A, 12) \
    HG_CP(B, 11) \
    HG_LD(B, 13) \
    HG_CP(A, 12) \
    HG_LD(A, 14) \
    HG_CP(B, 13) \
    HG_LD(B, 15) \
    HG_CP(A, 14) \
    HG_CP(B, 15) \
    } \
    } \
  }
#pragma unroll 1
  for (int c0 = 0; c0 < NCH; c0 += KD) {
    HG_BODY(0)
    if constexpr (KD > 1) { HG_BODY(1) HG_BODY(2) HG_BODY(3) }
  }
#undef HG_BODY
#undef HG_GLOAD
  __syncthreads();
  {
    const int pb = (NCH - 1) & 1, rowb = r0 + (NCH - 1) * TC;
#pragma unroll
    for (int i = 0; i < NL; ++i) {
      const int idx = tid + 256 * i;
      GO[(size_t)(rowb + (idx >> 5)) * 1024 + g * 128 + vg * 32 + (idx & 31)] = so[pb * TC * 32 + idx];
    }
  }
  float* ob = PROMPT ? p->out + O_PS + ((size_t)(bi * 8 + g) * 128) * 128 + vg * 32 : p->out + O_SS + ((size_t)((bi - 4) * 8 + g) * 128) * 128 + vg * 32;
  {
    float* st = lds + 5200 + (PROMPT ? 5500 : 0);
#pragma unroll
    for (int jj = 0; jj < 2; ++jj)
#pragma unroll
      for (int j4 = 0; j4 < 4; ++j4) {
        st[(jj * 64 + l16 * 4 + j4) * 33 + grp] = S0[jj * 4 + j4];
        st[(jj * 64 + l16 * 4 + j4) * 33 + grp + 16] = S1[jj * 4 + j4];
      }
    __syncthreads();
#pragma unroll
    for (int i = 0; i < 4; ++i) {
      const float* d = st + ((tid >> 3) + 32 * i) * 33 + (tid & 7) * 4;
      *(float4*)(ob + (size_t)((tid >> 3) + 32 * i) * 128 + (tid & 7) * 4) = make_float4(d[0], d[1], d[2], d[3]);
    }
  }
}

template <bool PROMPT>
__device__ __forceinline__ void rwkv_unit(KP p, float* lds, int bi, int h, int ig) {
  constexpr int TC = PROMPT ? 16 : 8;
  constexpr int NCH = PROMPT ? 128 : 1;
  constexpr int NV = TC / 8;
  constexpr int INSZ = TC * 64 * 5 + TC * 32;
  const int tid = TID(), l16 = tid & 15, grp = tid >> 4;
  const int r0 = PROMPT ? bi * 2048 : NPR + (bi - 4) * 8;
  const float* R = (const float*)(p->ws + W_R);
  const float* Kb = (const float*)(p->ws + W_K);
  const float* V = (const float*)(p->ws + W_V);
  const float* WP = (const float*)(p->ws + W_WP);
  const float* AP = (const float*)(p->ws + W_AP);
  float* Y = (float*)(p->ws + W_Y);
  float* so = lds + 2 * INSZ;
  const int irow = ig * 32 + grp;
  float4 S0, S1;
  if (!PROMPT) {
    const float* sb_ = p->in[I_RS] + ((size_t)((bi - 4) * 32 + h) * 64 + irow) * 64 + l16 * 4;
    S0 = *(const float4*)sb_;
    S1 = *(const float4*)(sb_ + 16 * 64);
  } else { S0 = make_float4(0, 0, 0, 0); S1 = S0; }
  const int cch = h * 64 + l16 * 4;
  const float4 w0 = *(const float4*)(p->in[I_RW0] + cch);
  const float4 a0 = *(const float4*)(p->in[I_RA0] + cch);
  const float4 kkw = *(const float4*)(p->in[I_RKK] + cch);
  const float4 kaw = *(const float4*)(p->in[I_RKA] + cch);
  const bool ldr = (grp < TC);
  constexpr int KD = PROMPT ? 4 : 1;
  float4 prr_0, prr_1, prr_2, prr_3, pkk_0, pkk_1, pkk_2, pkk_3, pww_0, pww_1, pww_2, pww_3, paa_0, paa_1, paa_2, paa_3;
  float pva_0 = 0.f, pva_1 = 0.f, pva_2 = 0.f, pva_3 = 0.f, pvb_0 = 0.f, pvb_1 = 0.f, pvb_2 = 0.f, pvb_3 = 0.f;
#define RW_GLOAD(j, c)                                                                                               \
  {                                                                                                                  \
    const int rowb = r0 + (c) * TC;                                                                                  \
    prr_##j = make_float4(0, 0, 0, 0); pkk_##j = prr_##j; pww_##j = prr_##j; paa_##j = prr_##j;                      \
    if (ldr) {                                                                                                       \
      const size_t ro = (size_t)(rowb + grp) * D + cch;                                                              \
      prr_##j = *(const float4*)(R + ro); pkk_##j = *(const float4*)(Kb + ro);                                       \
      pww_##j = *(const float4*)(WP + ro); paa_##j = *(const float4*)(AP + ro);                                      \
    }                                                                                                                \
    pva_##j = V[(size_t)(rowb + (tid >> 5)) * D + h * 64 + ig * 32 + (tid & 31)];                                    \
    if (NV > 1) pvb_##j = V[(size_t)(rowb + ((tid + 256) >> 5)) * D + h * 64 + ig * 32 + (tid & 31)];               \
  }
  RW_GLOAD(0, 0);
  if constexpr (KD > 1) { RW_GLOAD(1, 1); RW_GLOAD(2, 2); RW_GLOAD(3, 3); }
#define RW_BODY(j) { \
    const int c = c0 + j; \
    const int b = j & 1; \
    float* in = lds + b * INSZ; \
    const float4 pr = prr_##j, pk = pkk_##j, pw = pww_##j, pa = paa_##j; \
    if (ldr) { \
      float4 wp = pw; \
      wp.x += w0.x; wp.y += w0.y; wp.z += w0.z; wp.w += w0.w; \
      float4 kk; kk.x = pk.x * kkw.x; kk.y = pk.y * kkw.y; kk.z = pk.z * kkw.z; kk.w = pk.w * kkw.w; \
      float ss = kk.x * kk.x + kk.y * kk.y + kk.z * kk.z + kk.w * kk.w; \
      ss = row_sum16(ss); \
      const float inv = 1.f / fmaxf(sqrtf(ss), 1e-12f); \
      kk.x *= inv; kk.y *= inv; kk.z *= inv; kk.w *= inv; \
      float4 a; a.x = sigmoidf_(pa.x + a0.x); a.y = sigmoidf_(pa.y + a0.y); a.z = sigmoidf_(pa.z + a0.z); a.w = sigmoidf_(pa.w + a0.w); \
      float4 dw; \
      dw.x = __expf(-__expf(logsigmoidf_(wp.x) - 0.5f)); dw.y = __expf(-__expf(logsigmoidf_(wp.y) - 0.5f)); \
      dw.z = __expf(-__expf(logsigmoidf_(wp.z) - 0.5f)); dw.w = __expf(-__expf(logsigmoidf_(wp.w) - 0.5f)); \
      float4 kp; \
      kp.x = pk.x * (1.f + (a.x - 1.f) * kaw.x); kp.y = pk.y * (1.f + (a.y - 1.f) * kaw.y); \
      kp.z = pk.z * (1.f + (a.z - 1.f) * kaw.z); kp.w = pk.w * (1.f + (a.w - 1.f) * kaw.w); \
      const int o = grp * 64 + l16 * 4; \
      *(float4*)(in + o) = dw; \
      *(float4*)(in + TC * 64 + o) = make_float4(-kk.x, -kk.y, -kk.z, -kk.w); \
      *(float4*)(in + TC * 128 + o) = make_float4(kk.x * a.x, kk.y * a.y, kk.z * a.z, kk.w * a.w); \
      *(float4*)(in + TC * 192 + o) = kp; \
      *(float4*)(in + TC * 256 + o) = pr; \
    } \
    in[TC * 320 + tid] = pva_##j; if (NV > 1) in[TC * 320 + tid + 256] = pvb_##j; \
    LDS_BARRIER(); \
    if (c + KD < NCH) RW_GLOAD(j, c + KD); \
    if (c > 0) { \
      const int pb = b ^ 1, rowb = r0 + (c - 1) * TC; \
_Pragma("unroll") \
      for (int i = 0; i < NV; ++i) { \
        const int idx = tid + 256 * i; \
        Y[(size_t)(rowb + (idx >> 5)) * D + h * 64 + ig * 32 + (idx & 31)] = so[pb * TC * 32 + idx]; \
      } \
    } \
    { float4 Aw, Aa, Ab, Ak, Ar, Bw, Ba, Bb, Bk, Br; float Ava, Avb, Bva, Bvb; \
    RW_LD(A, 0) \
    RW_LD(B, 1) \
    RW_CP(A, 0) \
    RW_LD(A, 2) \
    RW_CP(B, 1) \
    RW_LD(B, 3) \
    RW_CP(A, 2) \
    RW_LD(A, 4) \
    RW_CP(B, 3) \
    RW_LD(B, 5) \
    RW_CP(A, 4) \
    RW_LD(A, 6) \
    RW_CP(B, 5) \
    RW_LD(B, 7) \
    RW_CP(A, 6) \
    if constexpr (TC == 16) { RW_LD(A, 8) } \
    RW_CP(B, 7) \
    if constexpr (TC == 16) { \
    RW_LD(B, 9) \
    RW_CP(A, 8) \
    RW_LD(A, 10) \
    RW_CP(B, 9) \
    RW_LD(B, 11) \
    RW_CP(A, 10) \
    RW_LD(A, 12) \
    RW_CP(B, 11) \
    RW_LD(B, 13) \
    RW_CP(A, 12) \
    RW_LD(A, 14) \
    RW_CP(B, 13) \
    RW_LD(B, 15) \
    RW_CP(A, 14) \
    RW_CP(B, 15) \
    } \
    } \
  }
#pragma unroll 1
  for (int c0 = 0; c0 < NCH; c0 += KD) {
    RW_BODY(0)
    if constexpr (KD > 1) { RW_BODY(1) RW_BODY(2) RW_BODY(3) }
  }
#undef RW_BODY
#undef RW_GLOAD
  __syncthreads();
  {
    const int pb = (NCH - 1) & 1, rowb = r0 + (NCH - 1) * TC;
#pragma unroll
    for (int i = 0; i < NV; ++i) {
      const int idx = tid + 256 * i;
      Y[(size_t)(rowb + (idx >> 5)) * D + h * 64 + ig * 32 + (idx & 31)] = so[pb * TC * 32 + idx];
    }
  }
  float* ob = PROMPT ? p->out + O_PRS + ((size_t)(bi * 32 + h) * 64 + irow) * 64 + l16 * 4
                     : p->out + O_SRS + ((size_t)((bi - 4) * 32 + h) * 64 + irow) * 64 + l16 * 4;
  *(float4*)ob = S0;
  *(float4*)(ob + 16 * 64) = S1;
}


__device__ __forceinline__ void ph_p0(KP p) {
  asm volatile("" : "+s"(p));
  char* lds = g_lds;
  int* s_unit = (int*)(g_lds + LDS_BYTES + 16);
  float* red = (float*)(g_lds + LDS_BYTES + 32);
  unsigned* ctr = (unsigned*)(p->ws + W_BAR) + 8192;
  const int tid = TID();
  const int G = gridDim.x;
  const int gtid = blockIdx.x * 256 + tid, gthreads = G * 256;
  u16* SCB = (u16*)(p->ws + W_SCB);
  float* MOD = (float*)(p->ws + W_MOD);
  u16* HA = (u16*)(p->ws + W_HA);
  u16* MIXED = (u16*)(p->ws + W_MIXED);
  float* X1 = (float*)(p->ws + W_X1);
  float* X2 = (float*)(p->ws + W_X2);
  float* Z = (float*)(p->ws + W_Z);
  float* QK = (float*)(p->ws + W_QK);
  u16* ACT = (u16*)(p->ws + W_ACT);
  u16* XMIX = (u16*)(p->ws + W_XMIX);
  (void)lds; (void)s_unit; (void)red; (void)ctr; (void)tid; (void)G; (void)gtid; (void)gthreads; (void)SCB; (void)MOD; (void)HA; (void)MIXED;
  (void)X1; (void)X2; (void)Z; (void)QK; (void)ACT; (void)XMIX;
  for (int i = gtid; i < 256 * D; i += gthreads) {
    const int r = i >> 11, c = i & 2047;
    float v = 0.f;
    if (r < 4) v = siluf_(p->in[I_CP][r * D + c]);
    else if (r < NB) v = siluf_(p->in[I_CS][(r - 4) * D + c]);
    SCB[i] = f2bf(v);
  }
  {
    u16* WT = (u16*)(p->ws + W_WT);
    int rot = 0;
    transpose_job(p->in[I_WIN], D, INW, WT + T_WIN, D, 8320, rot); rot += 32 * 130;
    transpose_job(p->in[I_WOUT], D, D, WT + T_WOUT, D, D, rot); rot += 1024;
    transpose_job(p->in[I_W1], D, DFF, WT + T_W1, D, DFF, rot); rot += 4096;
    if (G <= 256) transpose_job(p->in[I_W1] + (size_t)D * DFF, D, DFF, WT + T_W1 + (size_t)D * DFF, D, DFF, rot);
    rot += 4096;
    transpose_job(p->in[I_W2], DFF, D, WT + T_W2, DFF, D, rot); rot += 4096;
    if (G <= 256) transpose_job(p->in[I_W2] + (size_t)D * DFF, DFF, D, WT + T_W2 + (size_t)D * DFF, DFF, D, rot);
    rot += 4096;
    transpose_job(p->in[I_WR], D, D, WT + T_WR, D, D, rot); rot += 1024;
    transpose_job(p->in[I_WK], D, D, WT + T_WK, D, D, rot); rot += 1024;
    transpose_job(p->in[I_WV], D, D, WT + T_WV, D, D, rot); rot += 1024;
    transpose_job(p->in[I_WO], D, D, WT + T_WO, D, D, rot); rot += 1024;
    transpose_job(p->in[I_RW1], D, 96, WT + T_RW1, D, 128, rot); rot += 64;
    transpose_job(p->in[I_RA1], D, 96, WT + T_RA1, D, 128, rot); rot += 64;
    transpose_job(p->in[I_RG1], D, 256, WT + T_RG1, D, 256, rot); rot += 128;
    transpose_job(p->in[I_RW2], 96, D, WT + T_RW2, 128, D, rot); rot += 64;
    transpose_job(p->in[I_RA2], 96, D, WT + T_RA2, 128, D, rot); rot += 64;
    transpose_job(p->in[I_RG2], 256, D, WT + T_RG2, 256, D, rot);
  }
}

__device__ __forceinline__ void ph_p1(KP p) {
  asm volatile("" : "+s"(p));
  char* lds = g_lds;
  int* s_unit = (int*)(g_lds + LDS_BYTES + 16);
  float* red = (float*)(g_lds + LDS_BYTES + 32);
  unsigned* ctr = (unsigned*)(p->ws + W_BAR) + 8192;
  const int tid = TID();
  const int G = gridDim.x;
  const int gtid = blockIdx.x * 256 + tid, gthreads = G * 256;
  u16* SCB = (u16*)(p->ws + W_SCB);
  float* MOD = (float*)(p->ws + W_MOD);
  u16* HA = (u16*)(p->ws + W_HA);
  u16* MIXED = (u16*)(p->ws + W_MIXED);
  float* X1 = (float*)(p->ws + W_X1);
  float* X2 = (float*)(p->ws + W_X2);
  float* Z = (float*)(p->ws + W_Z);
  float* QK = (float*)(p->ws + W_QK);
  u16* ACT = (u16*)(p->ws + W_ACT);
  u16* XMIX = (u16*)(p->ws + W_XMIX);
  (void)lds; (void)s_unit; (void)red; (void)ctr; (void)tid; (void)G; (void)gtid; (void)gthreads; (void)SCB; (void)MOD; (void)HA; (void)MIXED;
  (void)X1; (void)X2; (void)Z; (void)QK; (void)ACT; (void)XMIX;
  for (int l = 0; l < 2; ++l) {
    float* mo = MOD + (size_t)l * NB * 12288;
    const float* bias = p->in[I_MODB] + (size_t)l * 12288;
    gemm_job(lds, SCB, D, p->in[I_MODW] + (size_t)l * D * 12288, 12288, 2, 12288, D, l * 192,
             EPI_ELEM(if (row < NB) mo[(unsigned)row * 12288 + col] = v + bias[col];));
  }
}

__device__ __forceinline__ void ph_norm0(KP p) {
  asm volatile("" : "+s"(p));
  char* lds = g_lds;
  int* s_unit = (int*)(g_lds + LDS_BYTES + 16);
  float* red = (float*)(g_lds + LDS_BYTES + 32);
  unsigned* ctr = (unsigned*)(p->ws + W_BAR) + 8192;
  const int tid = TID();
  const int G = gridDim.x;
  const int gtid = blockIdx.x * 256 + tid, gthreads = G * 256;
  u16* SCB = (u16*)(p->ws + W_SCB);
  float* MOD = (float*)(p->ws + W_MOD);
  u16* HA = (u16*)(p->ws + W_HA);
  u16* MIXED = (u16*)(p->ws + W_MIXED);
  float* X1 = (float*)(p->ws + W_X1);
  float* X2 = (float*)(p->ws + W_X2);
  float* Z = (float*)(p->ws + W_Z);
  float* QK = (float*)(p->ws + W_QK);
  u16* ACT = (u16*)(p->ws + W_ACT);
  u16* XMIX = (u16*)(p->ws + W_XMIX);
  (void)lds; (void)s_unit; (void)red; (void)ctr; (void)tid; (void)G; (void)gtid; (void)gthreads; (void)SCB; (void)MOD; (void)HA; (void)MIXED;
  (void)X1; (void)X2; (void)Z; (void)QK; (void)ACT; (void)XMIX;
  norm_pass<0>(p, red, [&](int r) { return xin_row(p, r); }, p->in[I_NMIX], 0, 0);
}

__device__ __forceinline__ void ph_p3(KP p) {
  asm volatile("" : "+s"(p));
  char* lds = g_lds;
  int* s_unit = (int*)(g_lds + LDS_BYTES + 16);
  float* red = (float*)(g_lds + LDS_BYTES + 32);
  unsigned* ctr = (unsigned*)(p->ws + W_BAR) + 8192;
  const int tid = TID();
  const int G = gridDim.x;
  const int gtid = blockIdx.x * 256 + tid, gthreads = G * 256;
  u16* SCB = (u16*)(p->ws + W_SCB);
  float* MOD = (float*)(p->ws + W_MOD);
  u16* HA = (u16*)(p->ws + W_HA);
  u16* MIXED = (u16*)(p->ws + W_MIXED);
  float* X1 = (float*)(p->ws + W_X1);
  float* X2 = (float*)(p->ws + W_X2);
  float* Z = (float*)(p->ws + W_Z);
  float* QK = (float*)(p->ws + W_QK);
  u16* ACT = (u16*)(p->ws + W_ACT);
  u16* XMIX = (u16*)(p->ws + W_XMIX);
  (void)lds; (void)s_unit; (void)red; (void)ctr; (void)tid; (void)G; (void)gtid; (void)gthreads; (void)SCB; (void)MOD; (void)HA; (void)MIXED;
  (void)X1; (void)X2; (void)Z; (void)QK; (void)ACT; (void)XMIX;
  gemm2_job(HA, D, (const u16*)(p->ws + W_WT) + T_WIN, D, 72, 65, INW, D, 0,
           EPI_ELEM(Z[(unsigned)row * INW + col] = v;));
}

__device__ __forceinline__ void ph_p4(KP p) {
  asm volatile("" : "+s"(p));
  char* lds = g_lds;
  int* s_unit = (int*)(g_lds + LDS_BYTES + 16);
  float* red = (float*)(g_lds + LDS_BYTES + 32);
  unsigned* ctr = (unsigned*)(p->ws + W_BAR) + 8192;
  const int tid = TID();
  const int G = gridDim.x;
  const int gtid = blockIdx.x * 256 + tid, gthreads = G * 256;
  u16* SCB = (u16*)(p->ws + W_SCB);
  float* MOD = (float*)(p->ws + W_MOD);
  u16* HA = (u16*)(p->ws + W_HA);
  u16* MIXED = (u16*)(p->ws + W_MIXED);
  float* X1 = (float*)(p->ws + W_X1);
  float* X2 = (float*)(p->ws + W_X2);
  float* Z = (float*)(p->ws + W_Z);
  float* QK = (float*)(p->ws + W_QK);
  u16* ACT = (u16*)(p->ws + W_ACT);
  u16* XMIX = (u16*)(p->ws + W_XMIX);
  (void)lds; (void)s_unit; (void)red; (void)ctr; (void)tid; (void)G; (void)gtid; (void)gthreads; (void)SCB; (void)MOD; (void)HA; (void)MIXED;
  (void)X1; (void)X2; (void)Z; (void)QK; (void)ACT; (void)XMIX;
  {
    const float* cw = p->in[I_CONVW];
    for (int i = gtid; i < (NTOK / 4) * 512; i += gthreads) {
      const int r0 = (i >> 9) * 4, c = (i & 511) * 4;
      int bi, t0, T;
      row_info(r0, bi, t0, T);
      float4 u[7];
#pragma unroll
      for (int j = 0; j < 7; ++j) {
        const int tt = t0 - 3 + j;
        if (tt >= 0) u[j] = *(const float4*)(Z + (size_t)(r0 - 3 + j) * INW + c);
        else if (bi >= 4) u[j] = *(const float4*)(p->in[I_MCONV] + ((size_t)(bi - 4) * 3 + (tt + 3)) * D + c);
        else u[j] = make_float4(0, 0, 0, 0);
      }
      float4 wv[4];
#pragma unroll
      for (int j = 0; j < 4; ++j) wv[j] = *(const float4*)(cw + j * D + c);
      const float s = (c >= 1024) ? 0.0625f : 1.f;
#pragma unroll
      for (int q = 0; q < 4; ++q) {
        float4 acc = make_float4(0, 0, 0, 0);
#pragma unroll
        for (int j = 0; j < 4; ++j) {
          acc.x += u[q + j].x * wv[j].x; acc.y += u[q + j].y * wv[j].y; acc.z += u[q + j].z * wv[j].z; acc.w += u[q + j].w * wv[j].w;
        }
        float4 o;
        o.x = siluf_(acc.x) * s; o.y = siluf_(acc.y) * s; o.z = siluf_(acc.z) * s; o.w = siluf_(acc.w) * s;
        *(float4*)(QK + (size_t)(r0 + q) * D + c) = o;
        const int t = t0 + q;
        if (t >= T - 3) {
          float* co = (bi < 4) ? p->out + O_PCONV + ((size_t)bi * 3 + (t - (T - 3))) * D + c
                               : p->out + O_SCONV + ((size_t)(bi - 4) * 3 + (t - (T - 3))) * D + c;
          *(float4*)co = u[q + 3];
        }
      }
    }
  }
}

__device__ __forceinline__ void ph_p5(KP p) {
  asm volatile("" : "+s"(p));
  char* lds = g_lds;
  int* s_unit = (int*)(g_lds + LDS_BYTES + 16);
  float* red = (float*)(g_lds + LDS_BYTES + 32);
  unsigned* ctr = (unsigned*)(p->ws + W_BAR) + 8192;
  const int tid = TID();
  const int G = gridDim.x;
  const int gtid = blockIdx.x * 256 + tid, gthreads = G * 256;
  u16* SCB = (u16*)(p->ws + W_SCB);
  float* MOD = (float*)(p->ws + W_MOD);
  u16* HA = (u16*)(p->ws + W_HA);
  u16* MIXED = (u16*)(p->ws + W_MIXED);
  float* X1 = (float*)(p->ws + W_X1);
  float* X2 = (float*)(p->ws + W_X2);
  float* Z = (float*)(p->ws + W_Z);
  float* QK = (float*)(p->ws + W_QK);
  u16* ACT = (u16*)(p->ws + W_ACT);
  u16* XMIX = (u16*)(p->ws + W_XMIX);
  (void)lds; (void)s_unit; (void)red; (void)ctr; (void)tid; (void)G; (void)gtid; (void)gthreads; (void)SCB; (void)MOD; (void)HA; (void)MIXED;
  (void)X1; (void)X2; (void)Z; (void)QK; (void)ACT; (void)XMIX;
  if (blockIdx.x < 256) {
    for (;;) {
      const int u = next_unit(ctr + 0, s_unit);
      if (u >= 256) break;
      mlstm_unit<true>(p, (float*)lds, u >> 6, (u >> 4) & 3, u & 15);
    }
  }
  for (;;) {
    const int u = next_unit(ctr + 16, s_unit);
    if (u >= 144) break;
    if (u < 16) mlstm_unit<true>(p, (float*)lds, u >> 2, u & 3, 16);
    else { const int v = u - 16; hgrn_unit<true>(p, (float*)lds, v >> 5, (v & 31) >> 2, v & 3); }
  }
  for (;;) {
    const int v = next_unit(ctr + 32, s_unit);
    if (v >= 12800) break;
    if (v < 8704) mlstm_unit<false>(p, (float*)lds, 4 + v / 68, (v % 68) / 17, v % 17);
    else { const int w = v - 8704; hgrn_unit<false>(p, (float*)lds, 4 + (w >> 5), (w & 31) >> 2, w & 3); }
  }
}

__device__ __forceinline__ void ph_p6(KP p) {
  asm volatile("" : "+s"(p));
  char* lds = g_lds;
  int* s_unit = (int*)(g_lds + LDS_BYTES + 16);
  float* red = (float*)(g_lds + LDS_BYTES + 32);
  unsigned* ctr = (unsigned*)(p->ws + W_BAR) + 8192;
  const int tid = TID();
  const int G = gridDim.x;
  const int gtid = blockIdx.x * 256 + tid, gthreads = G * 256;
  u16* SCB = (u16*)(p->ws + W_SCB);
  float* MOD = (float*)(p->ws + W_MOD);
  u16* HA = (u16*)(p->ws + W_HA);
  u16* MIXED = (u16*)(p->ws + W_MIXED);
  float* X1 = (float*)(p->ws + W_X1);
  float* X2 = (float*)(p->ws + W_X2);
  float* Z = (float*)(p->ws + W_Z);
  float* QK = (float*)(p->ws + W_QK);
  u16* ACT = (u16*)(p->ws + W_ACT);
  u16* XMIX = (u16*)(p->ws + W_XMIX);
  (void)lds; (void)s_unit; (void)red; (void)ctr; (void)tid; (void)G; (void)gtid; (void)gthreads; (void)SCB; (void)MOD; (void)HA; (void)MIXED;
  (void)X1; (void)X2; (void)Z; (void)QK; (void)ACT; (void)XMIX;
  {
    const int lane = tid & 63;
    const int gw = blockIdx.x * 4 + (tid >> 6), nw = G * 4;
    const float* MO = (const float*)(p->ws + W_MO);
    const float* GO = (const float*)(p->ws + W_GO);
    const float* DEN = (const float*)(p->ws + W_DEN);
    const float* MST = (const float*)(p->ws + W_MST);
    for (int task = gw; task < NTOK * 2; task += nw) {
      const int r = task >> 1;
      const float* zr = Z + (size_t)r * INW;
      if ((task & 1) == 0) {
        float4 nv[4], mo[4];
        float den[4], ms[4];
#pragma unroll
        for (int hh = 0; hh < 4; ++hh) {
          const int c = hh * 256 + lane * 4;
          nv[hh] = *(const float4*)(MO + (size_t)r * 1024 + c);
          mo[hh] = *(const float4*)(zr + 3072 + c);
          den[hh] = DEN[(size_t)r * 4 + hh]; ms[hh] = MST[(size_t)r * 4 + hh];
        }
#pragma unroll
        for (int hh = 0; hh < 4; ++hh) {
          const int c = hh * 256 + lane * 4;
          float4 n4 = nv[hh];
          const float inv = 1.f / fmaxf(fabsf(den[hh]), __expf(-ms[hh]));
          n4.x *= inv; n4.y *= inv; n4.z *= inv; n4.w *= inv;
          const float mean = wave_sum(n4.x + n4.y + n4.z + n4.w) * (1.f / 256.f);
          n4.x -= mean; n4.y -= mean; n4.z -= mean; n4.w -= mean;
          const float var = wave_sum(n4.x * n4.x + n4.y * n4.y + n4.z * n4.z + n4.w * n4.w) * (1.f / 256.f);
          const float rs = rsqrtf(var + 1e-6f);
          const float4 gn = *(const float4*)(p->in[I_MNORM] + c);
          uint2 o;
          o.x = pack2(sigmoidf_(mo[hh].x) * n4.x * rs * gn.x, sigmoidf_(mo[hh].y) * n4.y * rs * gn.y);
          o.y = pack2(sigmoidf_(mo[hh].z) * n4.z * rs * gn.z, sigmoidf_(mo[hh].w) * n4.w * rs * gn.w);
          *(uint2*)(MIXED + (size_t)r * D + c) = o;
        }
      } else {
        float4 ov[4], gg[4];
#pragma unroll
        for (int q = 0; q < 4; ++q) {
          const int c = (q * 2 + (lane >> 5)) * 128 + (lane & 31) * 4;
          ov[q] = *(const float4*)(GO + (size_t)r * 1024 + c);
          gg[q] = *(const float4*)(zr + 7176 + c);
        }
#pragma unroll
        for (int q = 0; q < 4; ++q) {
          const int c = (q * 2 + (lane >> 5)) * 128 + (lane & 31) * 4;
          float ssq = ov[q].x * ov[q].x + ov[q].y * ov[q].y + ov[q].z * ov[q].z + ov[q].w * ov[q].w;
          ssq = row_sum16(ssq);
          ssq += __shfl_xor(ssq, 16);
          const float rs = rsqrtf(ssq * (1.f / 128.f) + 1e-6f);
          const float4 gn = *(const float4*)(p->in[I_GNORM] + c);
          uint2 o;
          o.x = pack2(ov[q].x * rs * gn.x * siluf_(gg[q].x), ov[q].y * rs * gn.y * siluf_(gg[q].y));
          o.y = pack2(ov[q].z * rs * gn.z * siluf_(gg[q].z), ov[q].w * rs * gn.w * siluf_(gg[q].w));
          *(uint2*)(MIXED + (size_t)r * D + 1024 + c) = o;
        }
      }
    }
  }
}

__device__ __forceinline__ void ph_p7(KP p) {
  asm volatile("" : "+s"(p));
  char* lds = g_lds;
  int* s_unit = (int*)(g_lds + LDS_BYTES + 16);
  float* red = (float*)(g_lds + LDS_BYTES + 32);
  unsigned* ctr = (unsigned*)(p->ws + W_BAR) + 8192;
  const int tid = TID();
  const int G = gridDim.x;
  const int gtid = blockIdx.x * 256 + tid, gthreads = G * 256;
  u16* SCB = (u16*)(p->ws + W_SCB);
  float* MOD = (float*)(p->ws + W_MOD);
  u16* HA = (u16*)(p->ws + W_HA);
  u16* MIXED = (u16*)(p->ws + W_MIXED);
  float* X1 = (float*)(p->ws + W_X1);
  float* X2 = (float*)(p->ws + W_X2);
  float* Z = (float*)(p->ws + W_Z);
  float* QK = (float*)(p->ws + W_QK);
  u16* ACT = (u16*)(p->ws + W_ACT);
  u16* XMIX = (u16*)(p->ws + W_XMIX);
  (void)lds; (void)s_unit; (void)red; (void)ctr; (void)tid; (void)G; (void)gtid; (void)gthreads; (void)SCB; (void)MOD; (void)HA; (void)MIXED;
  (void)X1; (void)X2; (void)Z; (void)QK; (void)ACT; (void)XMIX;
  {
    const float* mod = MOD;
    KP pp = p;
    gemm2_job(MIXED, D, (const u16*)(p->ws + W_WT) + T_WOUT, D, 72, 16, D, D, 0, EPI_RESID(X1, ((rb < NPR) ? pp->in[I_XP] : pp->in[I_XS] - (size_t)NPR * D), mod, 2));
  }
}

__device__ __forceinline__ void ph_norm1(KP p) {
  asm volatile("" : "+s"(p));
  char* lds = g_lds;
  int* s_unit = (int*)(g_lds + LDS_BYTES + 16);
  float* red = (float*)(g_lds + LDS_BYTES + 32);
  unsigned* ctr = (unsigned*)(p->ws + W_BAR) + 8192;
  const int tid = TID();
  const int G = gridDim.x;
  const int gtid = blockIdx.x * 256 + tid, gthreads = G * 256;
  u16* SCB = (u16*)(p->ws + W_SCB);
  float* MOD = (float*)(p->ws + W_MOD);
  u16* HA = (u16*)(p->ws + W_HA);
  u16* MIXED = (u16*)(p->ws + W_MIXED);
  float* X1 = (float*)(p->ws + W_X1);
  float* X2 = (float*)(p->ws + W_X2);
  float* Z = (float*)(p->ws + W_Z);
  float* QK = (float*)(p->ws + W_QK);
  u16* ACT = (u16*)(p->ws + W_ACT);
  u16* XMIX = (u16*)(p->ws + W_XMIX);
  (void)lds; (void)s_unit; (void)red; (void)ctr; (void)tid; (void)G; (void)gtid; (void)gthreads; (void)SCB; (void)MOD; (void)HA; (void)MIXED;
  (void)X1; (void)X2; (void)Z; (void)QK; (void)ACT; (void)XMIX;
  norm_pass<1>(p, red, [&](int r) { return (const float*)(X2 + (size_t)r * D); }, p->in[I_NMIX] + D, 1, 0);
}

__device__ __forceinline__ void ph_p12(KP p) {
  asm volatile("" : "+s"(p));
  char* lds = g_lds;
  int* s_unit = (int*)(g_lds + LDS_BYTES + 16);
  float* red = (float*)(g_lds + LDS_BYTES + 32);
  unsigned* ctr = (unsigned*)(p->ws + W_BAR) + 8192;
  const int tid = TID();
  const int G = gridDim.x;
  const int gtid = blockIdx.x * 256 + tid, gthreads = G * 256;
  u16* SCB = (u16*)(p->ws + W_SCB);
  float* MOD = (float*)(p->ws + W_MOD);
  u16* HA = (u16*)(p->ws + W_HA);
  u16* MIXED = (u16*)(p->ws + W_MIXED);
  float* X1 = (float*)(p->ws + W_X1);
  float* X2 = (float*)(p->ws + W_X2);
  float* Z = (float*)(p->ws + W_Z);
  float* QK = (float*)(p->ws + W_QK);
  u16* ACT = (u16*)(p->ws + W_ACT);
  u16* XMIX = (u16*)(p->ws + W_XMIX);
  (void)lds; (void)s_unit; (void)red; (void)ctr; (void)tid; (void)G; (void)gtid; (void)gthreads; (void)SCB; (void)MOD; (void)HA; (void)MIXED;
  (void)X1; (void)X2; (void)Z; (void)QK; (void)ACT; (void)XMIX;
      {
        float* R = (float*)(p->ws + W_R); float* Kb = (float*)(p->ws + W_K); float* V = (float*)(p->ws + W_V);
        u16* L1A = (u16*)(p->ws + W_L1A); u16* L1B = (u16*)(p->ws + W_L1B); u16* L1G = (u16*)(p->ws + W_L1G);
        const size_t XS = (size_t)NTOK * D;
        gemm2_job(XMIX + 0 * XS, D, (const u16*)(p->ws + W_WT) + T_WR, D, 72, 16, D, D, 0, EPI_ELEM(R[(unsigned)row * D + col] = v;));
        gemm2_job(XMIX + 2 * XS, D, (const u16*)(p->ws + W_WT) + T_WK, D, 72, 16, D, D, 1152, EPI_ELEM(Kb[(unsigned)row * D + col] = v;));
        gemm2_job(XMIX + 3 * XS, D, (const u16*)(p->ws + W_WT) + T_WV, D, 72, 16, D, D, 2304, EPI_ELEM(V[(unsigned)row * D + col] = v;));
        gemm2_job(XMIX + 1 * XS, D, (const u16*)(p->ws + W_WT) + T_RW1, D, 72, 1, 128, D, 3456, EPI_ELEM(L1A[(unsigned)row * 128 + col] = f2bf(tanhf(v));));
        gemm2_job(XMIX + 4 * XS, D, (const u16*)(p->ws + W_WT) + T_RA1, D, 72, 1, 128, D, 3528, EPI_ELEM(L1B[(unsigned)row * 128 + col] = f2bf(v);));
        gemm2_job(XMIX + 5 * XS, D, (const u16*)(p->ws + W_WT) + T_RG1, D, 72, 2, 256, D, 3600, EPI_ELEM(L1G[(unsigned)row * 256 + col] = f2bf(sigmoidf_(v));));
      }
}

__device__ __forceinline__ void ph_p13(KP p) {
  asm volatile("" : "+s"(p));
  char* lds = g_lds;
  int* s_unit = (int*)(g_lds + LDS_BYTES + 16);
  float* red = (float*)(g_lds + LDS_BYTES + 32);
  unsigned* ctr = (unsigned*)(p->ws + W_BAR) + 8192;
  const int tid = TID();
  const int G = gridDim.x;
  const int gtid = blockIdx.x * 256 + tid, gthreads = G * 256;
  u16* SCB = (u16*)(p->ws + W_SCB);
  float* MOD = (float*)(p->ws + W_MOD);
  u16* HA = (u16*)(p->ws + W_HA);
  u16* MIXED = (u16*)(p->ws + W_MIXED);
  float* X1 = (float*)(p->ws + W_X1);
  float* X2 = (float*)(p->ws + W_X2);
  float* Z = (float*)(p->ws + W_Z);
  float* QK = (float*)(p->ws + W_QK);
  u16* ACT = (u16*)(p->ws + W_ACT);
  u16* XMIX = (u16*)(p->ws + W_XMIX);
  (void)lds; (void)s_unit; (void)red; (void)ctr; (void)tid; (void)G; (void)gtid; (void)gthreads; (void)SCB; (void)MOD; (void)HA; (void)MIXED;
  (void)X1; (void)X2; (void)Z; (void)QK; (void)ACT; (void)XMIX;
      {
        float* WP = (float*)(p->ws + W_WP); float* AP = (float*)(p->ws + W_AP); float* Gt = (float*)(p->ws + W_G);
        gemm2_job((const u16*)(p->ws + W_L1A), 128, (const u16*)(p->ws + W_WT) + T_RW2, 128, 72, 16, D, 128, 0, EPI_ELEM(WP[(unsigned)row * D + col] = v;));
        gemm2_job((const u16*)(p->ws + W_L1B), 128, (const u16*)(p->ws + W_WT) + T_RA2, 128, 72, 16, D, 128, 1152, EPI_ELEM(AP[(unsigned)row * D + col] = v;));
        gemm2_job((const u16*)(p->ws + W_L1G), 256, (const u16*)(p->ws + W_WT) + T_RG2, 256, 72, 16, D, 256, 2304, EPI_ELEM(Gt[(unsigned)row * D + col] = v;));
      }
}

__device__ __forceinline__ void ph_p14(KP p) {
  asm volatile("" : "+s"(p));
  char* lds = g_lds;
  int* s_unit = (int*)(g_lds + LDS_BYTES + 16);
  float* red = (float*)(g_lds + LDS_BYTES + 32);
  unsigned* ctr = (unsigned*)(p->ws + W_BAR) + 8192;
  const int tid = TID();
  const int G = gridDim.x;
  const int gtid = blockIdx.x * 256 + tid, gthreads = G * 256;
  u16* SCB = (u16*)(p->ws + W_SCB);
  float* MOD = (float*)(p->ws + W_MOD);
  u16* HA = (u16*)(p->ws + W_HA);
  u16* MIXED = (u16*)(p->ws + W_MIXED);
  float* X1 = (float*)(p->ws + W_X1);
  float* X2 = (float*)(p->ws + W_X2);
  float* Z = (float*)(p->ws + W_Z);
  float* QK = (float*)(p->ws + W_QK);
  u16* ACT = (u16*)(p->ws + W_ACT);
  u16* XMIX = (u16*)(p->ws + W_XMIX);
  (void)lds; (void)s_unit; (void)red; (void)ctr; (void)tid; (void)G; (void)gtid; (void)gthreads; (void)SCB; (void)MOD; (void)HA; (void)MIXED;
  (void)X1; (void)X2; (void)Z; (void)QK; (void)ACT; (void)XMIX;
      if (blockIdx.x < 256) {
        for (;;) {
          const int u = next_unit(ctr + 64, s_unit);
          if (u >= 256) break;
          rwkv_unit<true>(p, (float*)lds, u >> 6, (u & 63) >> 1, u & 1);
        }
      }
      for (;;) {
        const int v = next_unit(ctr + 80, s_unit);
        if (v >= 8192) break;
        rwkv_unit<false>(p, (float*)lds, 4 + (v >> 6), (v & 63) >> 1, v & 1);
      }
      if (G > 256 && blockIdx.x >= 256) {
        u16* WT = (u16*)(p->ws + W_WT);
        __syncthreads();
        transpose_job(p->in[I_W1] + (size_t)D * DFF, D, DFF, WT + T_W1 + (size_t)D * DFF, D, DFF, 0, G - 256, (int)blockIdx.x - 256);
        transpose_job(p->in[I_W2] + (size_t)D * DFF, DFF, D, WT + T_W2 + (size_t)D * DFF, DFF, D, 0, G - 256, (int)blockIdx.x - 256);
      }
}

__device__ __forceinline__ void ph_p15(KP p) {
  asm volatile("" : "+s"(p));
  char* lds = g_lds;
  int* s_unit = (int*)(g_lds + LDS_BYTES + 16);
  float* red = (float*)(g_lds + LDS_BYTES + 32);
  unsigned* ctr = (unsigned*)(p->ws + W_BAR) + 8192;
  const int tid = TID();
  const int G = gridDim.x;
  const int gtid = blockIdx.x * 256 + tid, gthreads = G * 256;
  u16* SCB = (u16*)(p->ws + W_SCB);
  float* MOD = (float*)(p->ws + W_MOD);
  u16* HA = (u16*)(p->ws + W_HA);
  u16* MIXED = (u16*)(p->ws + W_MIXED);
  float* X1 = (float*)(p->ws + W_X1);
  float* X2 = (float*)(p->ws + W_X2);
  float* Z = (float*)(p->ws + W_Z);
  float* QK = (float*)(p->ws + W_QK);
  u16* ACT = (u16*)(p->ws + W_ACT);
  u16* XMIX = (u16*)(p->ws + W_XMIX);
  (void)lds; (void)s_unit; (void)red; (void)ctr; (void)tid; (void)G; (void)gtid; (void)gthreads; (void)SCB; (void)MOD; (void)HA; (void)MIXED;
  (void)X1; (void)X2; (void)Z; (void)QK; (void)ACT; (void)XMIX;
      {
        const int lane = tid & 63, l16 = lane & 15, hq = lane >> 4;
        const int gw = blockIdx.x * 4 + (tid >> 6), nw = G * 4;
        const float* R = (const float*)(p->ws + W_R); const float* Kb = (const float*)(p->ws + W_K); const float* V = (const float*)(p->ws + W_V);
        const float* AP = (const float*)(p->ws + W_AP); const float* Gt = (const float*)(p->ws + W_G); const float* Y = (const float*)(p->ws + W_Y);
        for (int task0 = gw; task0 < NTOK * 8; task0 += 2 * nw) {
          float4 y[2], ap[2], kb[2], rv[2], vv[2], gt[2];
          unsigned oo[2]; int cc[2]; bool ok[2];
#pragma unroll
          for (int u = 0; u < 2; ++u) {
            const int task = task0 + u * nw;
            ok[u] = task < NTOK * 8;
            const int tk = ok[u] ? task : gw;
            cc[u] = ((tk & 7) * 4 + hq) * 64 + l16 * 4;
            oo[u] = (unsigned)(tk >> 3) * D + cc[u];
            y[u] = *(const float4*)(Y + oo[u]); ap[u] = *(const float4*)(AP + oo[u]); kb[u] = *(const float4*)(Kb + oo[u]);
            rv[u] = *(const float4*)(R + oo[u]); vv[u] = *(const float4*)(V + oo[u]); gt[u] = *(const float4*)(Gt + oo[u]);
          }
#pragma unroll
          for (int u = 0; u < 2; ++u) {
            const int c = cc[u];
            const float4 lnw = *(const float4*)(p->in[I_LNW] + c), lnb = *(const float4*)(p->in[I_LNB] + c);
            const float4 a0 = *(const float4*)(p->in[I_RA0] + c), ka = *(const float4*)(p->in[I_RKA] + c), rrk = *(const float4*)(p->in[I_RRK] + c);
            float4 yy = y[u];
            const float mean = row_sum16(yy.x + yy.y + yy.z + yy.w) * (1.f / 64.f);
            yy.x -= mean; yy.y -= mean; yy.z -= mean; yy.w -= mean;
            const float var = row_sum16(yy.x * yy.x + yy.y * yy.y + yy.z * yy.z + yy.w * yy.w) * (1.f / 64.f);
            const float rs = rsqrtf(var + 64e-5f);
            yy.x = yy.x * rs * lnw.x + lnb.x; yy.y = yy.y * rs * lnw.y + lnb.y; yy.z = yy.z * rs * lnw.z + lnb.z; yy.w = yy.w * rs * lnw.w + lnb.w;
            float4 kp;
            kp.x = kb[u].x * (1.f + (sigmoidf_(ap[u].x + a0.x) - 1.f) * ka.x); kp.y = kb[u].y * (1.f + (sigmoidf_(ap[u].y + a0.y) - 1.f) * ka.y);
            kp.z = kb[u].z * (1.f + (sigmoidf_(ap[u].z + a0.z) - 1.f) * ka.z); kp.w = kb[u].w * (1.f + (sigmoidf_(ap[u].w + a0.w) - 1.f) * ka.w);
            const float bon = row_sum16(rv[u].x * kp.x * rrk.x + rv[u].y * kp.y * rrk.y + rv[u].z * kp.z * rrk.z + rv[u].w * kp.w * rrk.w);
            uint2 o;
            o.x = pack2((yy.x + bon * vv[u].x) * gt[u].x, (yy.y + bon * vv[u].y) * gt[u].y);
            o.y = pack2((yy.z + bon * vv[u].z) * gt[u].z, (yy.w + bon * vv[u].w) * gt[u].w);
            if (ok[u]) *(uint2*)(MIXED + oo[u]) = o;
          }
        }
      }
}

__device__ __forceinline__ void ph_p16(KP p) {
  asm volatile("" : "+s"(p));
  char* lds = g_lds;
  int* s_unit = (int*)(g_lds + LDS_BYTES + 16);
  float* red = (float*)(g_lds + LDS_BYTES + 32);
  unsigned* ctr = (unsigned*)(p->ws + W_BAR) + 8192;
  const int tid = TID();
  const int G = gridDim.x;
  const int gtid = blockIdx.x * 256 + tid, gthreads = G * 256;
  u16* SCB = (u16*)(p->ws + W_SCB);
  float* MOD = (float*)(p->ws + W_MOD);
  u16* HA = (u16*)(p->ws + W_HA);
  u16* MIXED = (u16*)(p->ws + W_MIXED);
  float* X1 = (float*)(p->ws + W_X1);
  float* X2 = (float*)(p->ws + W_X2);
  float* Z = (float*)(p->ws + W_Z);
  float* QK = (float*)(p->ws + W_QK);
  u16* ACT = (u16*)(p->ws + W_ACT);
  u16* XMIX = (u16*)(p->ws + W_XMIX);
  (void)lds; (void)s_unit; (void)red; (void)ctr; (void)tid; (void)G; (void)gtid; (void)gthreads; (void)SCB; (void)MOD; (void)HA; (void)MIXED;
  (void)X1; (void)X2; (void)Z; (void)QK; (void)ACT; (void)XMIX;
      {
        const float* mod = MOD + (size_t)NB * 12288;
        gemm2_impl(MIXED, D, (const u16*)(p->ws + W_WT) + T_WO, D, 72, 16, D, D, 0, EPI_RESID(X1, X2, mod, 2), EPI_RESID_ATOMIC(X1, mod, 2), true);
      }
}

__device__ __forceinline__ void ph_normffn(KP p, int layer) {
  asm volatile("" : "+s"(p));
  char* lds = g_lds;
  int* s_unit = (int*)(g_lds + LDS_BYTES + 16);
  float* red = (float*)(g_lds + LDS_BYTES + 32);
  unsigned* ctr = (unsigned*)(p->ws + W_BAR) + 8192;
  const int tid = TID();
  const int G = gridDim.x;
  const int gtid = blockIdx.x * 256 + tid, gthreads = G * 256;
  u16* SCB = (u16*)(p->ws + W_SCB);
  float* MOD = (float*)(p->ws + W_MOD);
  u16* HA = (u16*)(p->ws + W_HA);
  u16* MIXED = (u16*)(p->ws + W_MIXED);
  float* X1 = (float*)(p->ws + W_X1);
  float* X2 = (float*)(p->ws + W_X2);
  float* Z = (float*)(p->ws + W_Z);
  float* QK = (float*)(p->ws + W_QK);
  u16* ACT = (u16*)(p->ws + W_ACT);
  u16* XMIX = (u16*)(p->ws + W_XMIX);
  (void)lds; (void)s_unit; (void)red; (void)ctr; (void)tid; (void)G; (void)gtid; (void)gthreads; (void)SCB; (void)MOD; (void)HA; (void)MIXED;
  (void)X1; (void)X2; (void)Z; (void)QK; (void)ACT; (void)XMIX;
  norm_pass<0>(p, red, [&](int r) { return (const float*)(X1 + (size_t)r * D); }, p->in[I_NFFN] + (size_t)layer * D, layer, 3);
}

__device__ __forceinline__ void ph_ffn1(KP p, int layer) {
  asm volatile("" : "+s"(p));
  char* lds = g_lds;
  int* s_unit = (int*)(g_lds + LDS_BYTES + 16);
  float* red = (float*)(g_lds + LDS_BYTES + 32);
  unsigned* ctr = (unsigned*)(p->ws + W_BAR) + 8192;
  const int tid = TID();
  const int G = gridDim.x;
  const int gtid = blockIdx.x * 256 + tid, gthreads = G * 256;
  u16* SCB = (u16*)(p->ws + W_SCB);
  float* MOD = (float*)(p->ws + W_MOD);
  u16* HA = (u16*)(p->ws + W_HA);
  u16* MIXED = (u16*)(p->ws + W_MIXED);
  float* X1 = (float*)(p->ws + W_X1);
  float* X2 = (float*)(p->ws + W_X2);
  float* Z = (float*)(p->ws + W_Z);
  float* QK = (float*)(p->ws + W_QK);
  u16* ACT = (u16*)(p->ws + W_ACT);
  u16* XMIX = (u16*)(p->ws + W_XMIX);
  (void)lds; (void)s_unit; (void)red; (void)ctr; (void)tid; (void)G; (void)gtid; (void)gthreads; (void)SCB; (void)MOD; (void)HA; (void)MIXED;
  (void)X1; (void)X2; (void)Z; (void)QK; (void)ACT; (void)XMIX;
    gemm2_job(HA, D, (const u16*)(p->ws + W_WT) + T_W1 + (size_t)layer * D * DFF, D, 72, 64, DFF, D, 0, EPI_ACT_PACKED(ACT));
}

__device__ __forceinline__ void ph_ffn2(KP p, int layer) {
  asm volatile("" : "+s"(p));
  char* lds = g_lds;
  int* s_unit = (int*)(g_lds + LDS_BYTES + 16);
  float* red = (float*)(g_lds + LDS_BYTES + 32);
  unsigned* ctr = (unsigned*)(p->ws + W_BAR) + 8192;
  const int tid = TID();
  const int G = gridDim.x;
  const int gtid = blockIdx.x * 256 + tid, gthreads = G * 256;
  u16* SCB = (u16*)(p->ws + W_SCB);
  float* MOD = (float*)(p->ws + W_MOD);
  u16* HA = (u16*)(p->ws + W_HA);
  u16* MIXED = (u16*)(p->ws + W_MIXED);
  float* X1 = (float*)(p->ws + W_X1);
  float* X2 = (float*)(p->ws + W_X2);
  float* Z = (float*)(p->ws + W_Z);
  float* QK = (float*)(p->ws + W_QK);
  u16* ACT = (u16*)(p->ws + W_ACT);
  u16* XMIX = (u16*)(p->ws + W_XMIX);
  (void)lds; (void)s_unit; (void)red; (void)ctr; (void)tid; (void)G; (void)gtid; (void)gthreads; (void)SCB; (void)MOD; (void)HA; (void)MIXED;
  (void)X1; (void)X2; (void)Z; (void)QK; (void)ACT; (void)XMIX;
    {
      const float* mod = MOD + (size_t)layer * NB * 12288;
      gemm2_impl(ACT, DFF, (const u16*)(p->ws + W_WT) + T_W2 + (size_t)layer * DFF * D, DFF, 72, 16, D, DFF, 0, EPI_RESID(X2, X1, mod, 5), EPI_RESID_ATOMIC(X2, mod, 5), true);
    }
}

__device__ __forceinline__ void ph_final(KP p) {
  asm volatile("" : "+s"(p));
  char* lds = g_lds;
  int* s_unit = (int*)(g_lds + LDS_BYTES + 16);
  float* red = (float*)(g_lds + LDS_BYTES + 32);
  unsigned* ctr = (unsigned*)(p->ws + W_BAR) + 8192;
  const int tid = TID();
  const int G = gridDim.x;
  const int gtid = blockIdx.x * 256 + tid, gthreads = G * 256;
  u16* SCB = (u16*)(p->ws + W_SCB);
  float* MOD = (float*)(p->ws + W_MOD);
  u16* HA = (u16*)(p->ws + W_HA);
  u16* MIXED = (u16*)(p->ws + W_MIXED);
  float* X1 = (float*)(p->ws + W_X1);
  float* X2 = (float*)(p->ws + W_X2);
  float* Z = (float*)(p->ws + W_Z);
  float* QK = (float*)(p->ws + W_QK);
  u16* ACT = (u16*)(p->ws + W_ACT);
  u16* XMIX = (u16*)(p->ws + W_XMIX);
  (void)lds; (void)s_unit; (void)red; (void)ctr; (void)tid; (void)G; (void)gtid; (void)gthreads; (void)SCB; (void)MOD; (void)HA; (void)MIXED;
  (void)X1; (void)X2; (void)Z; (void)QK; (void)ACT; (void)XMIX;
  norm_pass<2>(p, red, [&](int r) { return (const float*)(X2 + (size_t)r * D); }, p->in[I_FNORM], 0, 0);
}

__global__ void __launch_bounds__(256, 2) fwd_megakernel(Params p_unused) {
  cg::grid_group grid = cg::this_grid();
  KP p = (KP)__builtin_amdgcn_kernarg_segment_ptr();
#if !USE_CG_SYNC
  if (TID() == 0) { *(uint4*)(g_lds + LDS_BYTES) = make_uint4(0u, 0u, 0u, 0u); }
  __syncthreads();
  XcdBarrier xb = xcd_barrier_post((unsigned*)(p->ws + W_BAR), (volatile LAS unsigned*)(g_lds + LDS_BYTES));
#endif
  if (gridDim.x == 0x7fffffffu) grid.sync();
  ph_p0(p);
  GSYNC();
#pragma unroll 1
  for (int ph = 1; ph <= 20; ++ph) {
    switch (ph) {
      case 1: ph_p1(p); break;
      case 2: ph_norm0(p); break;
      case 3: ph_p3(p); break;
      case 4: ph_p4(p); break;
      case 5: ph_p5(p); break;
      case 6: ph_p6(p); break;
      case 7: ph_p7(p); break;
      case 8: case 17: ph_normffn(p, ph == 17 ? 1 : 0); break;
      case 9: case 18: ph_ffn1(p, ph == 18 ? 1 : 0); break;
      case 10: case 19: ph_ffn2(p, ph == 19 ? 1 : 0); break;
      case 11: ph_norm1(p); break;
      case 12: ph_p12(p); break;
      case 13: ph_p13(p); break;
      case 14: ph_p14(p); break;
      case 15: ph_p15(p); break;
      case 16: ph_p16(p); break;
      default: ph_final(p); break;
    }
    if (ph < 20) GSYNC();
  }
}

extern "C" void kernel_launch(void* const* d_in, const int* in_sizes, int n_in, void* d_out, int out_size, void* d_ws, size_t ws_size,
                              hipStream_t stream) {
  static int grid_blocks = 0;
  if (!grid_blocks) {
    int dev = 0, cus = 0, per_cu = 0;
    hipGetDevice(&dev);
    hipDeviceGetAttribute(&cus, hipDeviceAttributeMultiprocessorCount, dev);
    hipOccupancyMaxActiveBlocksPerMultiprocessor(&per_cu, fwd_megakernel, 256, 0);
    if (per_cu > 4) per_cu = 4;
    if (per_cu < 1) per_cu = 1;
    grid_blocks = cus * per_cu;
  }
  if (ws_size < W_END) fprintf(stderr, "workspace too small: %zu < %zu\n", ws_size, (size_t)W_END);
  Params p{};
  for (int i = 0; i < N_IN; ++i) p.in[i] = (const float*)d_in[i];
  p.out = (float*)d_out;
  p.ws = (char*)d_ws;
  hipMemsetAsync(d_ws, 0, 65536, stream);
  void* args[] = {&p};
  hipError_t e = hipLaunchCooperativeKernel((void*)fwd_megakernel, dim3(grid_blocks), dim3(256), args, 0, stream);
  if (e != hipSuccess) fprintf(stderr, "cooperative launch failed: %s (grid %d)\n", hipGetErrorString(e), grid_blocks);
}
```

```cpp
#include <hip/hip_runtime.h>
#include <hip/hip_cooperative_groups.h>
#include <cstdio>
#include <cstdint>
namespace cg = cooperative_groups;

#ifndef USE_CG_SYNC
#define USE_CG_SYNC 0
#endif

typedef __attribute__((ext_vector_type(8))) short bf16x8;
typedef __attribute__((ext_vector_type(16))) float f32x16;
typedef __attribute__((ext_vector_type(2))) float f32x2;
typedef __attribute__((ext_vector_type(2))) __bf16 bf16x2;
typedef unsigned short u16;
__device__ __forceinline__ int TID() { int t = (int)__builtin_amdgcn_workitem_id_x(); asm volatile("" : "+v"(t)); return t; }

#define LDS_BARRIER() do { asm volatile("s_waitcnt lgkmcnt(0)" ::: "memory"); __builtin_amdgcn_s_barrier(); asm volatile("" ::: "memory"); } while (0)

constexpr int D = 2048;
constexpr int NTOK = 9216;
constexpr int NPR = 8192;
constexpr int NB = 132;
constexpr int INW = 8200;
constexpr int DFF = 8192;

enum { I_XP = 0, I_XS, I_CP, I_CS, I_MC, I_MN, I_MM, I_MCONV, I_GS, I_RS, I_RSH, I_MODW, I_MODB, I_NMIX, I_NFFN,
       I_W1, I_W2, I_FNORM, I_WIN, I_GATEB, I_CONVW, I_MNORM, I_GLB, I_GNORM, I_WOUT, I_RMU, I_RW0, I_RW1, I_RW2,
       I_RA0, I_RA1, I_RA2, I_RG1, I_RG2, I_RKK, I_RKA, I_RRK, I_WR, I_WK, I_WV, I_WO, I_LNW, I_LNB, N_IN };

constexpr size_t O_Y = 0;
constexpr size_t O_PC = 18874368;
constexpr size_t O_PN = O_PC + 1048576;
constexpr size_t O_PM = O_PN + 4096;
constexpr size_t O_PCONV = O_PM + 16;
constexpr size_t O_PS = O_PCONV + 24576;
constexpr size_t O_PRS = O_PS + 524288;
constexpr size_t O_PSH = O_PRS + 524288;
constexpr size_t O_SC = O_PSH + 8192;
constexpr size_t O_SN = O_SC + 33554432;
constexpr size_t O_SM = O_SN + 131072;
constexpr size_t O_SCONV = O_SM + 512;
constexpr size_t O_SS = O_SCONV + 786432;
constexpr size_t O_SRS = O_SS + 16777216;
constexpr size_t O_SSH = O_SRS + 16777216;

constexpr size_t W_BAR = 0;
constexpr size_t W_SCB = 65536;
constexpr size_t W_MOD = W_SCB + 256 * 2048 * 2;
constexpr size_t W_HA = W_MOD + 2ull * 132 * 12288 * 4;
constexpr size_t W_MIXED = W_HA;
constexpr size_t W_X1 = W_HA + 9216ull * 2048 * 2;
constexpr size_t W_X2 = W_X1;
constexpr size_t W_DEN = W_X1 + 9216ull * 2048 * 4;
constexpr size_t W_MST = W_DEN + 9216ull * 4 * 4;
constexpr size_t W_L1A = W_MST + 9216ull * 4 * 4;
constexpr size_t W_L1B = W_L1A + 9216ull * 128 * 2;
constexpr size_t W_L1G = W_L1B + 9216ull * 128 * 2;
constexpr size_t W_RA = W_L1G + 9216ull * 256 * 2;
constexpr size_t W_Z = W_RA;
constexpr size_t W_QK = W_Z + 9216ull * 8200 * 4;
constexpr size_t W_MO = W_QK + 9216ull * 2048 * 4;
constexpr size_t W_GO = W_MO + 9216ull * 1024 * 4;
constexpr size_t W_RA_END = W_GO + 9216ull * 1024 * 4;
constexpr size_t SZ_TOKD = 9216ull * 2048 * 4;
constexpr size_t W_R = W_RA;
constexpr size_t W_K = W_R + SZ_TOKD;
constexpr size_t W_V = W_K + SZ_TOKD;
constexpr size_t W_WP = W_V + SZ_TOKD;
constexpr size_t W_AP = W_WP + SZ_TOKD;
constexpr size_t W_G = W_AP + SZ_TOKD;
constexpr size_t W_XMIX = W_WP;
static_assert(W_G + SZ_TOKD <= W_RA_END, "region A too small");
constexpr size_t W_RB = W_RA_END;
constexpr size_t W_ACT = W_RB;
constexpr size_t W_Y = W_RB;
constexpr size_t W_WT = W_RB + 9216ull * 8192 * 2;
constexpr size_t T_WIN = 0;
constexpr size_t T_WOUT = T_WIN + 8320ull * 2048;
constexpr size_t T_W1 = T_WOUT + 2048ull * 2048;
constexpr size_t T_W2 = T_W1 + 2ull * 8192 * 2048;
constexpr size_t T_WR = T_W2 + 2ull * 8192 * 2048;
constexpr size_t T_WK = T_WR + 2048ull * 2048;
constexpr size_t T_WV = T_WK + 2048ull * 2048;
constexpr size_t T_WO = T_WV + 2048ull * 2048;
constexpr size_t T_RW1 = T_WO + 2048ull * 2048;
constexpr size_t T_RA1 = T_RW1 + 128ull * 2048;
constexpr size_t T_RG1 = T_RA1 + 128ull * 2048;
constexpr size_t T_RW2 = T_RG1 + 256ull * 2048;
constexpr size_t T_RA2 = T_RW2 + 2048ull * 128;
constexpr size_t T_RG2 = T_RA2 + 2048ull * 128;
constexpr size_t T_END = T_RG2 + 2048ull * 256;
constexpr size_t W_END = W_WT + T_END * 2;

struct Params {
  const float* in[N_IN];
  float* out;
  char* ws;
};
typedef const Params __attribute__((address_space(4)))* KP;

__device__ __forceinline__ unsigned pack2(float a, float b) {
  f32x2 v = {a, b};
  bf16x2 r = __builtin_convertvector(v, bf16x2);
  return __builtin_bit_cast(unsigned, r);
}
__device__ __forceinline__ u16 f2bf(float a) { return (u16)(pack2(a, 0.f) & 0xffffu); }
template <int CTRL> __device__ __forceinline__ float dpp_mov(float x) {
  return __int_as_float(__builtin_amdgcn_update_dpp(0, __float_as_int(x), CTRL, 0xF, 0xF, false));
}
__device__ __forceinline__ float row_sum16(float x) {
  x += dpp_mov<0x128>(x);
  x += dpp_mov<0x124>(x);
  x += dpp_mov<0x122>(x);
  x += dpp_mov<0x121>(x);
  return x;
}
__device__ __forceinline__ float wave_sum(float x) {
  x = row_sum16(x);
  x += __shfl_xor(x, 16);
  x += __shfl_xor(x, 32);
  return x;
}
__device__ __forceinline__ float sigmoidf_(float x) { return 1.f / (1.f + __expf(-x)); }
__device__ __forceinline__ float siluf_(float x) { return x / (1.f + __expf(-x)); }
__device__ __forceinline__ float logsigmoidf_(float x) { return fminf(x, 0.f) - __logf(1.f + __expf(-fabsf(x))); }

__device__ __forceinline__ void row_info(int r, int& bi, int& t, int& T) {
  if (r < NPR) { bi = r >> 11; t = r & 2047; T = 2048; }
  else { int q = r - NPR; bi = 4 + (q >> 3); t = q & 7; T = 8; }
}
__device__ __forceinline__ const float* xin_row(KP p, int r) {
  return (r < NPR) ? p->in[I_XP] + (size_t)r * D : p->in[I_XS] + (size_t)(r - NPR) * D;
}

#if USE_CG_SYNC
#define GSYNC() grid.sync()
#else
#define XB_TMO      128
#define XB_XCNT(j)  (256  + 64 * (j))
#define XB_XSUB(j)  (1280 + 64 * (j))
#define XB_XGEN(j)  (2304 + 64 * (j))
#define XB_TOP      3328
#define XB_TOPGEN   3392
#define XB_SPIN_CAP (1u << 22)
#define LAS __attribute__((address_space(3)))
__device__ __forceinline__ unsigned xb_ld(unsigned* p) { return __hip_atomic_load(p, __ATOMIC_RELAXED, __HIP_MEMORY_SCOPE_AGENT); }
__device__ __forceinline__ unsigned xb_add(unsigned* p, unsigned v) { return __hip_atomic_fetch_add(p, v, __ATOMIC_RELAXED, __HIP_MEMORY_SCOPE_AGENT); }
__device__ __forceinline__ unsigned xb_xcc_id() { return (unsigned)__builtin_amdgcn_s_getreg((3 << 11) | 20) & 0xFu; }
#define XB_SPIN(cond, bar) do { unsigned _sp = 0; while (cond) { __builtin_amdgcn_s_sleep(1); \
    if ((++_sp & 255u) == 0u) { if (xb_ld(&(bar)[XB_TMO])) break; if (_sp > XB_SPIN_CAP) { atomicAdd(&(bar)[XB_TMO], 1u); break; } } } } while (0)
struct XcdBarrier { unsigned* bar; unsigned x; volatile LAS unsigned* st; };
__device__ __forceinline__ XcdBarrier xcd_barrier_post(unsigned* bar, volatile LAS unsigned* st) {
  XcdBarrier b; b.bar = bar; b.x = xb_xcc_id(); b.st = st;
  if (TID() == 0) (void)xb_add(&bar[XB_XCNT(b.x)], 1u);
  return b;
}
__device__ __forceinline__ void xcd_barrier_complete(unsigned* bar, unsigned x, unsigned& nloc, unsigned& nx) {
  const unsigned G = gridDim.x;
  unsigned sum, cnt, mine, sp = 0u;
  for (;;) {
    sum = 0u; cnt = 0u; mine = 0u;
#pragma unroll
    for (unsigned j = 0; j < 16; ++j) { const unsigned c = xb_ld(&bar[XB_XCNT(j)]); sum += c; cnt += (c > 0u) ? 1u : 0u; mine = (j == x) ? c : mine; }
    if (sum == G) break;
    __builtin_amdgcn_s_sleep(1);
    if ((++sp & 255u) == 0u) { if (xb_ld(&bar[XB_TMO])) break; if (sp > XB_SPIN_CAP) { atomicAdd(&bar[XB_TMO], 1u); break; } }
  }
  nloc = mine > 0u ? mine : 1u; nx = cnt > 0u ? cnt : 1u;
}
__device__ __forceinline__ void xcd_barrier(const XcdBarrier& b) {
  asm volatile("s_waitcnt vmcnt(0)" ::: "memory");
  __syncthreads();
  if (TID() == 0) {
    unsigned* bar = b.bar;
    __builtin_amdgcn_s_waitcnt(0);
    unsigned nloc = b.st[0], nx = b.st[1];
    if (nloc == 0u) { xcd_barrier_complete(bar, b.x, nloc, nx); b.st[0] = nloc; b.st[1] = nx; }
    const unsigned old = xb_add(&bar[XB_XSUB(b.x)], 1u);
    const unsigned gen = old / nloc;
    if (old + 1u == (gen + 1u) * nloc) {
      __builtin_amdgcn_fence(__ATOMIC_RELEASE, "agent");
      asm volatile("s_waitcnt vmcnt(0)" ::: "memory");
      const unsigned og = xb_add(&bar[XB_TOP], 1u);
      const unsigned tg = og / nx;
      if (og + 1u == (tg + 1u) * nx) xb_add(&bar[XB_TOPGEN], 1u);
      else XB_SPIN(xb_ld(&bar[XB_TOPGEN]) == tg, bar);
      __builtin_amdgcn_fence(__ATOMIC_ACQUIRE, "agent");
      xb_add(&bar[XB_XGEN(b.x)], 1u);
      asm volatile("s_waitcnt vmcnt(0)" ::: "memory");
    } else {
      XB_SPIN(xb_ld(&bar[XB_XGEN(b.x)]) == gen, bar);
      __builtin_amdgcn_fence(__ATOMIC_ACQUIRE, "agent");
      asm volatile("s_waitcnt vmcnt(0)" ::: "memory");
    }
  }
  __syncthreads();
}
#define GSYNC() xcd_barrier(xb)
#endif

constexpr int GL_STRIDE = 80;
constexpr int GL_BUF = 256 * GL_STRIDE;
constexpr int LDS_BYTES = 65536;

#define EPI_ELEM(...) [=](int rb, int ro, int col, float v0, float v1, float v2, float v3) { \
    { const int row = rb + ro + 0; const float v = v0; __VA_ARGS__ } { const int row = rb + ro + 1; const float v = v1; __VA_ARGS__ } \
    { const int row = rb + ro + 2; const float v = v2; __VA_ARGS__ } { const int row = rb + ro + 3; const float v = v3; __VA_ARGS__ } }
#define EPI_RESID(DST, SRCEXPR, MODP, CH) [=](int rb, int ro, int col, float v0, float v1, float v2, float v3) { \
    const int bi = (rb < NPR) ? (rb >> 11) : 4 + ((rb - NPR) >> 3); \
    const float g = (MODP)[(unsigned)((bi * 6 + (CH)) * D + col)]; \
    const float* xb = SRCEXPR; \
    const unsigned o = (unsigned)(rb + ro) * D + col; \
    DST[o] = xb[o] + g * v0; DST[o + D] = xb[o + D] + g * v1; DST[o + 2 * D] = xb[o + 2 * D] + g * v2; DST[o + 3 * D] = xb[o + 3 * D] + g * v3; }
template <class Epi>
__device__ __forceinline__ void gemm_job(char* lds, const u16* __restrict__ A, int lda, const float* __restrict__ B, int ldb,
                                         int Mt, int N, int K, int rot, Epi epi) {
  const int tid = TID(), lane = tid & 63, w = tid >> 6;
  const int ntn = (N + 127) >> 7;
  const int ntiles = Mt * ntn;
  const int G = gridDim.x;
  const int start = (int)((blockIdx.x + (unsigned)G - (unsigned)(rot % G)) % (unsigned)G);
  const int ar = tid >> 2, ac = tid & 3;
  const int np = tid & 63, ko = tid >> 6;
  const int wm = w >> 1, wn = w & 1;
  const int fr = lane & 31, fh = lane >> 5;
  const int nk = K >> 5;
  for (int tile = start; tile < ntiles; tile += G) {
    const int tm = tile % Mt, tn = tile / Mt;
    const int m0 = tm * 128, n0 = tn * 128;
    f32x16 acc[2][2];
#pragma unroll
    for (int i = 0; i < 2; ++i)
#pragma unroll
      for (int j = 0; j < 2; ++j)
#pragma unroll
        for (int r = 0; r < 16; ++r) acc[i][j][r] = 0.f;
    const u16* Ap0 = A + (size_t)(m0 + ar) * lda + ac * 8;
    const u16* Ap1 = Ap0 + (size_t)64 * lda;
    const int bcol = n0 + 2 * np;
    const bool bval = bcol < N;
    const float* Bp = B + (size_t)(ko * 8) * ldb + (bval ? bcol : 0);
    uint4 ra0_0, ra1_0, ra0_1, ra1_1;
    float2 rb_0[8], rb_1[8];
#define GJ_LOAD(s, k0) { ra0_##s = *(const uint4*)(Ap0 + (k0)); ra1_##s = *(const uint4*)(Ap1 + (k0));                 \
      _Pragma("unroll") for (int j = 0; j < 8; ++j) rb_##s[j] = *(const float2*)(Bp + (size_t)((k0) + j) * ldb); }
#define GJ_WRITE(s, buf) {                                                                                             \
      *(uint4*)((buf) + ar * GL_STRIDE + ac * 16) = ra0_##s;                                                            \
      *(uint4*)((buf) + (ar + 64) * GL_STRIDE + ac * 16) = ra1_##s;                                                     \
      char* bb = (buf) + 128 * GL_STRIDE;                                                                               \
      uint4 lo, hi;                                                                                                     \
      if (bval) {                                                                                                       \
        lo.x = pack2(rb_##s[0].x, rb_##s[1].x); lo.y = pack2(rb_##s[2].x, rb_##s[3].x); lo.z = pack2(rb_##s[4].x, rb_##s[5].x); lo.w = pack2(rb_##s[6].x, rb_##s[7].x); \
        hi.x = pack2(rb_##s[0].y, rb_##s[1].y); hi.y = pack2(rb_##s[2].y, rb_##s[3].y); hi.z = pack2(rb_##s[4].y, rb_##s[5].y); hi.w = pack2(rb_##s[6].y, rb_##s[7].y); \
      } else { lo = make_uint4(0, 0, 0, 0); hi = lo; }                                                                  \
      *(uint4*)(bb + (2 * np) * GL_STRIDE + ko * 16) = lo;                                                              \
      *(uint4*)(bb + (2 * np + 1) * GL_STRIDE + ko * 16) = hi; }
#define GJ_MMA(cur) {                                                                                                  \
      __builtin_amdgcn_s_setprio(1);                                                                                    \
      _Pragma("unroll") for (int kk = 0; kk < 2; ++kk) {                                                                \
        bf16x8 a[2], b[2];                                                                                              \
        _Pragma("unroll") for (int mi = 0; mi < 2; ++mi) a[mi] = *(const bf16x8*)((cur) + (wm * 64 + mi * 32 + fr) * GL_STRIDE + kk * 32 + fh * 16); \
        _Pragma("unroll") for (int ni = 0; ni < 2; ++ni) b[ni] = *(const bf16x8*)((cur) + (128 + wn * 64 + ni * 32 + fr) * GL_STRIDE + kk * 32 + fh * 16); \
        _Pragma("unroll") for (int mi = 0; mi < 2; ++mi) _Pragma("unroll") for (int ni = 0; ni < 2; ++ni)               \
          acc[mi][ni] = __builtin_amdgcn_mfma_f32_32x32x16_bf16(a[mi], b[ni], acc[mi][ni], 0, 0, 0); }                   \
      __builtin_amdgcn_s_setprio(0); }
    char* const lds0 = lds;
    char* const lds1 = lds + GL_BUF;
    GJ_LOAD(0, 0)
    GJ_WRITE(0, lds0)
    if (nk > 1) GJ_LOAD(1, 32)
    if (nk > 2) GJ_LOAD(0, 64)
    __syncthreads();
    for (int it = 0; it < nk; it += 2) {
      GJ_MMA(lds0)
      if (it + 1 < nk) { GJ_WRITE(1, lds1) if (it + 3 < nk) GJ_LOAD(1, (it + 3) * 32) }
      LDS_BARRIER();
      GJ_MMA(lds1)
      if (it + 2 < nk) { GJ_WRITE(0, lds0) if (it + 4 < nk) GJ_LOAD(0, (it + 4) * 32) }
      LDS_BARRIER();
    }
#undef GJ_LOAD
#undef GJ_WRITE
#undef GJ_MMA
    __syncthreads();
    {
      const int wmu = __builtin_amdgcn_readfirstlane(wm), wnu = __builtin_amdgcn_readfirstlane(wn);
#pragma unroll
      for (int mi = 0; mi < 2; ++mi)
#pragma unroll
        for (int ni = 0; ni < 2; ++ni) {
          const int col = n0 + wnu * 64 + ni * 32 + fr;
          if (col < N) {
#pragma unroll
            for (int rq = 0; rq < 4; ++rq) {
              const int rbase = m0 + wmu * 64 + mi * 32 + 8 * rq;
              epi(rbase, 4 * fh, col, acc[mi][ni][rq * 4 + 0], acc[mi][ni][rq * 4 + 1], acc[mi][ni][rq * 4 + 2], acc[mi][ni][rq * 4 + 3]);
              __builtin_amdgcn_sched_barrier(0);
            }
          }
        }
    }
  }
}

__shared__ __attribute__((aligned(16))) char g_lds[LDS_BYTES + 64];

#ifndef USE_GLDS
#define USE_GLDS 0
#endif
#if USE_GLDS
#define GLDS16(gp, lp) __builtin_amdgcn_global_load_lds((const unsigned*)(gp), (unsigned*)(lp), 16, 0, 0)
#else
#define GLDS16(gp, lp) (*(uint4*)(lp) = *(const uint4*)(gp))
#endif
#define EPI_RESID_ATOMIC(DST, MODP, CH) [=](int rb, int ro, int col, float v0, float v1, float v2, float v3) { \
    const int rr_ = rb + ro; const int bi = (rr_ < NPR) ? (rr_ >> 11) : 4 + ((rr_ - NPR) >> 3); \
    const float g = (MODP)[(unsigned)((bi * 6 + (CH)) * D + col)]; \
    const unsigned o = (unsigned)(rb + ro) * D + col; \
    unsafeAtomicAdd(&DST[o], g * v0); unsafeAtomicAdd(&DST[o + D], g * v1); unsafeAtomicAdd(&DST[o + 2 * D], g * v2); unsafeAtomicAdd(&DST[o + 3 * D], g * v3); }
template <class Epi, class Epi2>
__device__ __forceinline__ void gemm2_impl(const u16* __restrict__ A, int lda, const u16* __restrict__ Bt, int ldb,
                                           int Mt, int Nt, int N, int K, int rot, Epi epi, Epi2 epi2, bool split) {
  const int tid = TID(), lane = tid & 63, w = tid >> 6;
  const int ntiles = Mt * Nt;
  const int G = gridDim.x;
  const int start = (int)((blockIdx.x + (unsigned)G - (unsigned)(rot % G)) % (unsigned)G);
  const int wm = w >> 1, wn = w & 1;
  const int fr = lane & 31, fh = lane >> 5;
  const int nk = K >> 6;
  const int lrow = tid >> 3, lpos = tid & 7;
  const int sw = (lpos ^ ((lrow >> 1) & 7)) * 8;
  auto body = [&](int tile, int kit0, int nkp, auto&& ep) {
    const int tm = tile % Mt, tn = tile / Mt;
    const int m0 = tm * 128, n0 = tn * 128;
    f32x16 acc[2][2];
#pragma unroll
    for (int i = 0; i < 2; ++i)
#pragma unroll
      for (int j = 0; j < 2; ++j)
#pragma unroll
        for (int r = 0; r < 16; ++r) acc[i][j][r] = 0.f;
    const u16* ga = A + (size_t)(m0 + lrow) * lda + sw + kit0 * 64;
    const u16* gb = Bt + (size_t)(n0 + lrow) * ldb + sw + kit0 * 64;
    auto compute = [&](int stage) {
      const char* sA = g_lds + stage * 32768;
      const char* sB = sA + 16384;
      __builtin_amdgcn_s_setprio(1);
#pragma unroll
      for (int kk = 0; kk < 4; ++kk) {
        bf16x8 a[2], b[2];
#pragma unroll
        for (int mi = 0; mi < 2; ++mi) {
          const int r = wm * 64 + mi * 32 + fr;
          a[mi] = *(const bf16x8*)(sA + r * 128 + (((kk * 2 + fh) ^ ((r >> 1) & 7)) * 16));
        }
#pragma unroll
        for (int ni = 0; ni < 2; ++ni) {
          const int r = wn * 64 + ni * 32 + fr;
          b[ni] = *(const bf16x8*)(sB + r * 128 + (((kk * 2 + fh) ^ ((r >> 1) & 7)) * 16));
        }
#pragma unroll
        for (int mi = 0; mi < 2; ++mi)
#pragma unroll
          for (int ni = 0; ni < 2; ++ni) acc[mi][ni] = __builtin_amdgcn_mfma_f32_32x32x16_bf16(a[mi], b[ni], acc[mi][ni], 0, 0, 0);
      }
      __builtin_amdgcn_s_setprio(0);
    };
#if USE_GLDS
    auto issue = [&](int stage, int k0) {
#pragma unroll
      for (int i = 0; i < 4; ++i) GLDS16(ga + (size_t)i * 32 * lda + k0, g_lds + stage * 32768 + tid * 16 + i * 4096);
#pragma unroll
      for (int i = 0; i < 4; ++i) GLDS16(gb + (size_t)i * 32 * ldb + k0, g_lds + stage * 32768 + 16384 + tid * 16 + i * 4096);
    };
    issue(0, 0);
    for (int it = 0; it < nkp; ++it) {
      asm volatile("s_waitcnt vmcnt(0)" ::: "memory");
      __syncthreads();
      __builtin_amdgcn_s_sleep(4);
      __syncthreads();
      if (it + 1 < nkp) issue((it + 1) & 1, (it + 1) * 64);
      compute(it & 1);
    }
#else
    uint4 ra0, ra1, ra2, ra3, rb0, rb1, rb2, rb3;
    auto gload = [&](int k0) {
      ra0 = *(const uint4*)(ga + k0);
      ra1 = *(const uint4*)(ga + (size_t)32 * lda + k0);
      ra2 = *(const uint4*)(ga + (size_t)64 * lda + k0);
      ra3 = *(const uint4*)(ga + (size_t)96 * lda + k0);
      rb0 = *(const uint4*)(gb + k0);
      rb1 = *(const uint4*)(gb + (size_t)32 * ldb + k0);
      rb2 = *(const uint4*)(gb + (size_t)64 * ldb + k0);
      rb3 = *(const uint4*)(gb + (size_t)96 * ldb + k0);
    };
    auto lwrite = [&](int stage) {
      char* d = g_lds + stage * 32768 + tid * 16;
      *(uint4*)(d) = ra0; *(uint4*)(d + 4096) = ra1; *(uint4*)(d + 8192) = ra2; *(uint4*)(d + 12288) = ra3;
      *(uint4*)(d + 16384) = rb0; *(uint4*)(d + 20480) = rb1; *(uint4*)(d + 24576) = rb2; *(uint4*)(d + 28672) = rb3;
    };
    gload(0);
    lwrite(0);
    if (nkp > 1) gload(64);
    __syncthreads();
    for (int it = 0; it < nkp; ++it) {
      compute(it & 1);
      __builtin_amdgcn_sched_barrier(0);
      if (it + 1 < nkp) {
        lwrite((it + 1) & 1);
        __builtin_amdgcn_sched_barrier(0);
        if (it + 2 < nkp) gload((it + 2) * 64);
      }
      LDS_BARRIER();
    }
#endif
    __syncthreads();
    {
      const int wmu = __builtin_amdgcn_readfirstlane(wm), wnu = __builtin_amdgcn_readfirstlane(wn);
#pragma unroll
      for (int mi = 0; mi < 2; ++mi)
#pragma unroll
        for (int ni = 0; ni < 2; ++ni) {
          const int col = n0 + wnu * 64 + ni * 32 + fr;
          if (col < N) {
#pragma unroll
            for (int rq = 0; rq < 4; ++rq) {
              const int rbase = m0 + wmu * 64 + mi * 32 + 8 * rq;
              ep(rbase, 4 * fh, col, acc[mi][ni][rq * 4 + 0], acc[mi][ni][rq * 4 + 1], acc[mi][ni][rq * 4 + 2], acc[mi][ni][rq * 4 + 3]);
              __builtin_amdgcn_sched_barrier(0);
            }
          }
        }
    }
  };
  int main_tiles = ntiles, tail = 0;
  if (split) {
    const int full = ntiles / G;
    tail = ntiles - full * G;
    if (tail > 0 && tail * 4 <= G && (nk & 3) == 0) main_tiles = full * G; else tail = 0;
  }
  for (int tile = start; tile < main_tiles; tile += G) body(tile, 0, nk, epi);
  if (tail > 0 && (int)blockIdx.x < tail * 4) {
    const int wq = (int)blockIdx.x / tail, wt = (int)blockIdx.x - wq * tail;
    body(main_tiles + wt, wq * (nk >> 2), nk >> 2, epi2);
  }
}
template <class Epi>
__device__ __forceinline__ void gemm2_job(const u16* __restrict__ A, int lda, const u16* __restrict__ Bt, int ldb,
                                          int Mt, int Nt, int N, int K, int rot, Epi epi) {
  gemm2_impl(A, lda, Bt, ldb, Mt, Nt, N, K, rot, epi, epi, false);
}

__device__ __forceinline__ void transpose_job(const float* __restrict__ src, int K, int N, u16* __restrict__ dst, int Kpad, int Npad, int rot,
                                              int nb = 0, int bid = 0) {
  float* tl = (float*)g_lds;
  const int tid = TID();
  const int tk_n = Kpad >> 6, ntiles = tk_n * (Npad >> 6);
  const int G = nb ? nb : (int)gridDim.x;
  const int bx = nb ? bid : (int)blockIdx.x;
  const int start = (int)(((unsigned)bx + (unsigned)G - (unsigned)(rot % G)) % (unsigned)G);
  for (int tile = start; tile < ntiles; tile += G) {
    const int k0 = (tile % tk_n) * 64, n0 = (tile / tk_n) * 64;
    __syncthreads();
#pragma unroll
    for (int i = 0; i < 4; ++i) {
      const int kk = (tid >> 4) + 16 * i, n4 = (tid & 15) * 4;
      float4 v = make_float4(0, 0, 0, 0);
      if (k0 + kk < K && n0 + n4 < N) v = *(const float4*)(src + (size_t)(k0 + kk) * N + n0 + n4);
      float* d = tl + kk * 65 + n4;
      d[0] = v.x; d[1] = v.y; d[2] = v.z; d[3] = v.w;
    }
    __syncthreads();
#pragma unroll
    for (int i = 0; i < 2; ++i) {
      const int n = (tid >> 3) + 32 * i, c = tid & 7;
      const float* s = tl + (c * 8) * 65 + n;
      uint4 o;
      o.x = pack2(s[0], s[65]); o.y = pack2(s[130], s[195]); o.z = pack2(s[260], s[325]); o.w = pack2(s[390], s[455]);
      *(uint4*)(dst + (size_t)(n0 + n) * Kpad + k0 + c * 8) = o;
    }
  }
}

__device__ __forceinline__ float block_sum(float v, float* red) {
  v = wave_sum(v);
  __syncthreads();
  if ((TID() & 63) == 0) red[TID() >> 6] = v;
  __syncthreads();
  return red[0] + red[1] + red[2] + red[3];
}
template <int MODE, class XRow>
__device__ __forceinline__ void norm_pass(KP p, float* red_unused, XRow xrow, const float* __restrict__ gam, int layer, int modbase) {
  constexpr int NR = (MODE == 1) ? 9 : 8;
  constexpr int R0 = (MODE == 1) ? -1 : 0;
  const int tid = TID(), lane = tid & 63, w = tid >> 6;
  float* red = (float*)g_lds;
  const float* MOD = (const float*)(p->ws + W_MOD) + (size_t)layer * NB * 12288;
  u16* HA = (u16*)(p->ws + W_HA);
  u16* XM = (u16*)(p->ws + W_XMIX);
  for (int task = blockIdx.x; task < NTOK / 8; task += gridDim.x) {
    const int rb = task * 8;
    int bi, t0, T;
    row_info(rb, bi, t0, T);
    const float* sh = MOD + ((size_t)bi * 6 + modbase) * D;
    const float* sc = sh + D;
    float4 x[NR][2];
    float ss[NR];
#pragma unroll
    for (int i = 0; i < NR; ++i) {
      int r = rb + R0 + i;
      if (MODE == 1 && i == 0 && t0 == 0) r = rb;
      const float* xr = xrow(r);
      x[i][0] = *(const float4*)(xr + tid * 4);
      x[i][1] = *(const float4*)(xr + 1024 + tid * 4);
    }
#pragma unroll
    for (int i = 0; i < NR; ++i) {
      ss[i] = x[i][0].x * x[i][0].x + x[i][0].y * x[i][0].y + x[i][0].z * x[i][0].z + x[i][0].w * x[i][0].w +
              x[i][1].x * x[i][1].x + x[i][1].y * x[i][1].y + x[i][1].z * x[i][1].z + x[i][1].w * x[i][1].w;
      ss[i] = wave_sum(ss[i]);
    }
    __syncthreads();
    if (lane == 0) {
#pragma unroll
      for (int i = 0; i < NR; ++i) red[w * NR + i] = ss[i];
    }
    __syncthreads();
#pragma unroll
    for (int j = 0; j < 2; ++j) {
      const int c = j * 1024 + tid * 4;
      const float4 g = *(const float4*)(gam + c);
      float4 a = make_float4(0, 0, 0, 0), b = a;
      if (MODE != 2) { a = *(const float4*)(sc + c); b = *(const float4*)(sh + c); }
#pragma unroll
      for (int i = 0; i < NR; ++i) {
        const float rstd = rsqrtf((red[i] + red[NR + i] + red[2 * NR + i] + red[3 * NR + i]) * (1.f / D) + 1e-6f);
        float4 h;
        h.x = x[i][j].x * rstd * g.x; h.y = x[i][j].y * rstd * g.y; h.z = x[i][j].z * rstd * g.z; h.w = x[i][j].w * rstd * g.w;
        if (MODE != 2) { h.x = h.x * (1.f + a.x) + b.x; h.y = h.y * (1.f + a.y) + b.y; h.z = h.z * (1.f + a.z) + b.z; h.w = h.w * (1.f + a.w) + b.w; }
        x[i][j] = h;
        const int r = rb + R0 + i;
        if (MODE == 0) {
          uint2 o; o.x = pack2(h.x, h.y); o.y = pack2(h.z, h.w);
          *(uint2*)(HA + (size_t)r * D + c) = o;
        } else if (MODE == 2) {
          *(float4*)(p->out + O_Y + (size_t)r * D + c) = h;
        }
      }
      if (MODE == 1) {
        float4 pv = x[0][j];
        if (t0 == 0) pv = (bi >= 4) ? *(const float4*)(p->in[I_RSH] + (size_t)(bi - 4) * D + c) : make_float4(0, 0, 0, 0);
#pragma unroll
        for (int i = 1; i < NR; ++i) {
          const int r = rb + i - 1;
          const float4 h = x[i][j];
#pragma unroll 1
          for (int q = 0; q < 6; ++q) {
            const float4 mu = *(const float4*)(p->in[I_RMU] + (size_t)q * D + c);
            uint2 o;
            o.x = pack2(h.x + (pv.x - h.x) * mu.x, h.y + (pv.y - h.y) * mu.y);
            o.y = pack2(h.z + (pv.z - h.z) * mu.z, h.w + (pv.w - h.w) * mu.w);
            *(uint2*)(XM + ((size_t)q * NTOK + r) * D + c) = o;
          }
          if (t0 + i - 1 == T - 1) {
            float* so = (bi < 4) ? p->out + O_PSH + (size_t)bi * D : p->out + O_SSH + (size_t)(bi - 4) * D;
            *(float4*)(so + c) = h;
          }
          pv = h;
        }
      }
    }
  }
}

__device__ __forceinline__ int next_unit(unsigned* ctr, int* s_unit) {
  __syncthreads();
  if (TID() == 0) *s_unit = (int)atomicAdd(ctr, 1u);
  __syncthreads();
  return *s_unit;
}
__device__ __forceinline__ int publish_unit(int nxt, int* s_unit) {
  __syncthreads();
  if (TID() == 0) *s_unit = nxt;
  __syncthreads();
  return *s_unit;
}


__device__ __forceinline__ float fma_(float a, float b, float c) { float d; asm("v_fma_f32 %0, %1, %2, %3" : "=v"(d) : "v"(a), "v"(b), "v"(c)); return d; }
__device__ __forceinline__ float mul_(float a, float b) { float d; asm("v_mul_f32 %0, %1, %2" : "=v"(d) : "v"(a), "v"(b)); return d; }
__device__ __forceinline__ float sub_(float a, float b) { float d; asm("v_sub_f32 %0, %1, %2" : "=v"(d) : "v"(a), "v"(b)); return d; }
__device__ __forceinline__ float row_sum16_asm(float x) { asm volatile("s_nop 1"); return row_sum16(x + 0.f * x); }
#define ML_LD(S, t)                                                                                                   \
  S##q0 = *(const float4*)(in + (t) * 256 + 0 * 64 + l16 * 4); S##k0 = *(const float4*)(in + TC * 256 + (t) * 256 + 0 * 64 + l16 * 4); \
  S##q1 = *(const float4*)(in + (t) * 256 + 1 * 64 + l16 * 4); S##k1 = *(const float4*)(in + TC * 256 + (t) * 256 + 1 * 64 + l16 * 4); \
  S##q2 = *(const float4*)(in + (t) * 256 + 2 * 64 + l16 * 4); S##k2 = *(const float4*)(in + TC * 256 + (t) * 256 + 2 * 64 + l16 * 4); \
  S##q3 = *(const float4*)(in + (t) * 256 + 3 * 64 + l16 * 4); S##k3 = *(const float4*)(in + TC * 256 + (t) * 256 + 3 * 64 + l16 * 4); \
  S##fp = sfp[t]; S##iv = sip[t] * in[TC * 512 + (t) * 16 + grp];
#define ML_M(S, jj, e, x) tt_[jj * 4 + e] = mul_(S##k##jj.x, S##iv);
#define ML_U(S, jj, e, x) C[jj * 4 + e] = fma_(S##fp, C[jj * 4 + e], tt_[jj * 4 + e]);
#define ML_A(S, jj, e, x) acc##e = fma_(S##q##jj.x, C[jj * 4 + e], acc##e);
#define ML_ALL(OP, S) OP(S, 0, 0, x) OP(S, 0, 1, y) OP(S, 0, 2, z) OP(S, 0, 3, w) OP(S, 1, 0, x) OP(S, 1, 1, y) OP(S, 1, 2, z) OP(S, 1, 3, w) \
                      OP(S, 2, 0, x) OP(S, 2, 1, y) OP(S, 2, 2, z) OP(S, 2, 3, w) OP(S, 3, 0, x) OP(S, 3, 1, y) OP(S, 3, 2, z) OP(S, 3, 3, w)
#define ML_CP(S, t) { float tt_[16]; float acc0 = 0.f, acc1 = 0.f, acc2 = 0.f, acc3 = 0.f; ML_ALL(ML_M, S) ML_ALL(ML_U, S) ML_ALL(ML_A, S) \
  float acc = row_sum16_asm((acc0 + acc1) + (acc2 + acc3)); if (l16 == 0) so[b * TC * 16 + (t) * 16 + grp] = acc; }

#define HG_LD(S, t)                                                                                                   \
  S##q0 = *(const float4*)(in + (t) * 128 + l16 * 4); S##q1 = *(const float4*)(in + (t) * 128 + 64 + l16 * 4);         \
  S##f0 = *(const float4*)(in + TC * 128 + (t) * 128 + l16 * 4); S##f1 = *(const float4*)(in + TC * 128 + (t) * 128 + 64 + l16 * 4); \
  S##va = in[TC * 256 + (t) * 32 + grp]; S##vb = in[TC * 256 + (t) * 32 + 16 + grp];
#define HG_D(S, jj, e, x) d0_[jj * 4 + e] = sub_(S0[jj * 4 + e], S##va); d1_[jj * 4 + e] = sub_(S1[jj * 4 + e], S##vb);
#define HG_U(S, jj, e, x) S0[jj * 4 + e] = fma_(S##f##jj.x, d0_[jj * 4 + e], S##va); S1[jj * 4 + e] = fma_(S##f##jj.x, d1_[jj * 4 + e], S##vb);
#define HG_A(S, jj, e, x) a0##e = fma_(S##q##jj.x, S0[jj * 4 + e], a0##e); a1##e = fma_(S##q##jj.x, S1[jj * 4 + e], a1##e);
#define HG_ALL(OP, S) OP(S, 0, 0, x) OP(S, 0, 1, y) OP(S, 0, 2, z) OP(S, 0, 3, w) OP(S, 1, 0, x) OP(S, 1, 1, y) OP(S, 1, 2, z) OP(S, 1, 3, w)
#define HG_CP(S, t) { float d0_[8], d1_[8]; float a00 = 0.f, a01 = 0.f, a02 = 0.f, a03 = 0.f, a10 = 0.f, a11 = 0.f, a12 = 0.f, a13 = 0.f; \
  HG_ALL(HG_D, S) HG_ALL(HG_U, S) HG_ALL(HG_A, S)                                                                       \
  float acc0 = row_sum16_asm((a00 + a01) + (a02 + a03)); float acc1 = row_sum16_asm((a10 + a11) + (a12 + a13));        \
  if (l16 == 0) { so[b * TC * 32 + (t) * 32 + grp] = acc0; so[b * TC * 32 + (t) * 32 + 16 + grp] = acc1; } }

#define RW_LD(S, t)                                                                                                   \
  S##w = *(const float4*)(in + (t) * 64 + l16 * 4); S##a = *(const float4*)(in + TC * 64 + (t) * 64 + l16 * 4);        \
  S##b = *(const float4*)(in + TC * 128 + (t) * 64 + l16 * 4); S##k = *(const float4*)(in + TC * 192 + (t) * 64 + l16 * 4); \
  S##r = *(const float4*)(in + TC * 256 + (t) * 64 + l16 * 4);                                                         \
  S##va = in[TC * 320 + (t) * 32 + grp]; S##vb = in[TC * 320 + (t) * 32 + 16 + grp];
#define RW_UP(X, sa, vv, S, c) X.c = fma_(X.c, S##w.c, fma_(sa, S##b.c, mul_(vv, S##k.c)));
#define RW_DOT2(r0_, r1_, V) { float p0 = mul_(S0.x, V.x), p1 = mul_(S1.x, V.x), p2 = mul_(S0.y, V.y), p3 = mul_(S1.y, V.y);       \
    p0 = fma_(S0.z, V.z, p0); p1 = fma_(S1.z, V.z, p1); p2 = fma_(S0.w, V.w, p2); p3 = fma_(S1.w, V.w, p3); r0_ = p0 + p2; r1_ = p1 + p3; }
#define RW_CP(S, t) {                                                                                                 \
  float sa0, sa1; RW_DOT2(sa0, sa1, S##a)                                                                              \
  sa0 = row_sum16_asm(sa0); sa1 = row_sum16_asm(sa1);                                                                 \
  RW_UP(S0, sa0, S##va, S, x) RW_UP(S1, sa1, S##vb, S, x) RW_UP(S0, sa0, S##va, S, y) RW_UP(S1, sa1, S##vb, S, y)      \
  RW_UP(S0, sa0, S##va, S, z) RW_UP(S1, sa1, S##vb, S, z) RW_UP(S0, sa0, S##va, S, w) RW_UP(S1, sa1, S##vb, S, w)      \
  float y0, y1; RW_DOT2(y0, y1, S##r)                                                                                  \
  y0 = row_sum16_asm(y0); y1 = row_sum16_asm(y1);                                                                     \
  if (l16 == 0) { so[b * TC * 32 + (t) * 32 + grp] = y0; so[b * TC * 32 + (t) * 32 + 16 + grp] = y1; } }

template <bool PROMPT>
__device__ __forceinline__ void mlstm_unit(KP p, float* lds, int bi, int h, int eg) {
  constexpr int TC = 8;
  constexpr int NCH = PROMPT ? 256 : 1;
  constexpr int INSZ = TC * 512 + TC * 16 + 32;
  const int tid = TID(), l16 = tid & 15, grp = tid >> 4;
  const int r0 = PROMPT ? bi * 2048 : NPR + (bi - 4) * 8;
  const float* Z = (const float*)(p->ws + W_Z);
  const float* QK = (const float*)(p->ws + W_QK);
  float* MO = (float*)(p->ws + W_MO);
  float* DEN = (float*)(p->ws + W_DEN);
  float* MST = (float*)(p->ws + W_MST);
  float* so = lds + 2 * INSZ;
  float* sfp = so + 2 * TC * 16;
  float* sip = sfp + 16;
  float* smp = sip + 16;
  float* smc = smp + 32;
  float C[16];
  const int e = eg * 16 + grp;
  if (!PROMPT) {
    const int bs = bi - 4;
    if (eg < 16) {
      const float* base = p->in[I_MC] + ((size_t)(bs * 4 + h) * 256) * 256 + eg * 16;
      float* st = lds + 9000;
      float4 sv4[4];
#pragma unroll
      for (int i = 0; i < 4; ++i) sv4[i] = *(const float4*)(base + (size_t)((tid >> 2) + 64 * i) * 256 + (tid & 3) * 4);
#pragma unroll
      for (int i = 0; i < 4; ++i) {
        float* d = st + ((tid >> 2) + 64 * i) * 17 + (tid & 3) * 4;
        d[0] = sv4[i].x; d[1] = sv4[i].y; d[2] = sv4[i].z; d[3] = sv4[i].w;
      }
      __syncthreads();
#pragma unroll
      for (int jj = 0; jj < 4; ++jj)
#pragma unroll
        for (int j4 = 0; j4 < 4; ++j4) C[jj * 4 + j4] = st[(jj * 64 + l16 * 4 + j4) * 17 + grp];
    } else {
      const float* base = p->in[I_MN] + (size_t)(bs * 4 + h) * 256;
#pragma unroll
      for (int jj = 0; jj < 4; ++jj)
#pragma unroll
        for (int j4 = 0; j4 < 4; ++j4) C[jj * 4 + j4] = (grp == 0) ? base[jj * 64 + l16 * 4 + j4] : 0.f;
    }
    if (tid == 0) smc[0] = p->in[I_MM][bs * 4 + h];
  } else {
#pragma unroll
    for (int i = 0; i < 16; ++i) C[i] = 0.f;
    if (tid == 0) smc[0] = 0.f;
  }
  const float gbi = p->in[I_GATEB][h], gbf = p->in[I_GATEB][4 + h];
  constexpr int KD = PROMPT ? 4 : 1;
  float4 pq0_0, pq0_1, pq0_2, pq0_3, pq1_0, pq1_1, pq1_2, pq1_3, pk0_0, pk0_1, pk0_2, pk0_3, pk1_0, pk1_1, pk1_2, pk1_3;
  float pv_0, pv_1, pv_2, pv_3, pgi_0, pgi_1, pgi_2, pgi_3, pgf_0, pgf_1, pgf_2, pgf_3;
#define ML_GLOAD(j, c)                                                                                               \
  {                                                                                                                  \
    const int rowb = r0 + (c) * TC;                                                                                  \
    { const int idx = tid; const float* src = QK + (size_t)(rowb + (idx >> 6)) * D + h * 256 + (idx & 63) * 4;       \
      pq0_##j = *(const float4*)src; pk0_##j = *(const float4*)(src + 1024); }                                         \
    { const int idx = tid + 256; const float* src = QK + (size_t)(rowb + (idx >> 6)) * D + h * 256 + (idx & 63) * 4; \
      pq1_##j = *(const float4*)src; pk1_##j = *(const float4*)(src + 1024); }                                         \
    pv_##j = 0.f; pgi_##j = 0.f; pgf_##j = 0.f;                                                                         \
    if (tid < TC * 16) {                                                                                             \
      const int t = tid >> 4, ee = tid & 15;                                                                         \
      pv_##j = (eg < 16) ? Z[(size_t)(rowb + t) * INW + 2048 + h * 256 + eg * 16 + ee] : (ee == 0 ? 1.f : 0.f);       \
    }                                                                                                                \
    if (tid < TC) { const float* zr = Z + (size_t)(rowb + tid) * INW; pgi_##j = zr[4096 + h]; pgf_##j = zr[4100 + h]; } \
  }
  ML_GLOAD(0, 0);
  if constexpr (KD > 1) { ML_GLOAD(1, 1); ML_GLOAD(2, 2); ML_GLOAD(3, 3); }
#define ML_BODY(j) { \
    const int c = c0 + j; \
    const int b = j & 1; \
    float* in = lds + b * INSZ; \
    *(float4*)(in + tid * 4) = pq0_##j; \
    *(float4*)(in + (tid + 256) * 4) = pq1_##j; \
    *(float4*)(in + TC * 256 + tid * 4) = pk0_##j; \
    *(float4*)(in + TC * 256 + (tid + 256) * 4) = pk1_##j; \
    if (tid < TC * 16) in[TC * 512 + tid] = pv_##j; \
    if (tid < TC) { in[TC * 528 + tid] = pgi_##j + gbi; in[TC * 528 + 16 + tid] = logsigmoidf_(pgf_##j + gbf); } \
    LDS_BARRIER(); \
    if (c + KD < NCH) ML_GLOAD(j, c + KD); \
    if (tid < 16) { \
      const int t = tid; \
      float a = 0.f, bb = -1e30f; \
      if (t < TC) { bb = in[TC * 528 + t]; a = in[TC * 528 + 16 + t]; } \
      float A = a, B = bb; \
      { const float A2 = dpp_mov<0x111>(A), B2 = dpp_mov<0x111>(B); if (t >= 1) { B = fmaxf(B2 + A, B); A = A2 + A; } } \
      { const float A2 = dpp_mov<0x112>(A), B2 = dpp_mov<0x112>(B); if (t >= 2) { B = fmaxf(B2 + A, B); A = A2 + A; } } \
      { const float A2 = dpp_mov<0x114>(A), B2 = dpp_mov<0x114>(B); if (t >= 4) { B = fmaxf(B2 + A, B); A = A2 + A; } } \
      const float mm = smc[0]; \
      const float mt = fmaxf(mm + A, B); \
      float mprev = dpp_mov<0x111>(mt); \
      if (t == 0) mprev = mm; \
      sfp[t] = __expf(a + mprev - mt); \
      sip[t] = __expf(bb - mt); \
      smp[b * 16 + t] = mt; \
      if (t == TC - 1) smc[0] = mt; \
    } \
    if (c > 0) { \
      const int pb = b ^ 1, rowb = r0 + (c - 1) * TC; \
      if (eg < 16) { \
        if (tid < TC * 16) MO[(size_t)(rowb + (tid >> 4)) * 1024 + h * 256 + eg * 16 + (tid & 15)] = so[pb * TC * 16 + tid]; \
      } else if (tid < TC) { \
        DEN[(size_t)(rowb + tid) * 4 + h] = so[pb * TC * 16 + tid * 16]; \
        MST[(size_t)(rowb + tid) * 4 + h] = smp[pb * 16 + tid]; \
      } \
    } \
    LDS_BARRIER(); \
    { float4 Aq0, Aq1, Aq2, Aq3, Ak0, Ak1, Ak2, Ak3, Bq0, Bq1, Bq2, Bq3, Bk0, Bk1, Bk2, Bk3; float Afp, Aiv, Bfp, Biv; \
    ML_LD(A, 0) \
    ML_LD(B, 1) \
    ML_CP(A, 0) \
    ML_LD(A, 2) \
    ML_CP(B, 1) \
    ML_LD(B, 3) \
    ML_CP(A, 2) \
    ML_LD(A, 4) \
    ML_CP(B, 3) \
    ML_LD(B, 5) \
    ML_CP(A, 4) \
    ML_LD(A, 6) \
    ML_CP(B, 5) \
    ML_LD(B, 7) \
    ML_CP(A, 6) \
    ML_CP(B, 7) \
    } \
  }
#pragma unroll 1
  for (int c0 = 0; c0 < NCH; c0 += KD) {
    ML_BODY(0)
    if constexpr (KD > 1) { ML_BODY(1) ML_BODY(2) ML_BODY(3) }
  }
#undef ML_BODY
#undef ML_GLOAD
  __syncthreads();
  {
    const int pb = (NCH - 1) & 1, rowb = r0 + (NCH - 1) * TC;
    if (eg < 16) {
      if (tid < TC * 16) MO[(size_t)(rowb + (tid >> 4)) * 1024 + h * 256 + eg * 16 + (tid & 15)] = so[pb * TC * 16 + tid];
    } else if (tid < TC) {
      DEN[(size_t)(rowb + tid) * 4 + h] = so[pb * TC * 16 + tid * 16];
      MST[(size_t)(rowb + tid) * 4 + h] = smp[pb * 16 + tid];
    }
  }
  if (eg < 16) {
    float* ob = PROMPT ? p->out + O_PC + ((size_t)(bi * 4 + h) * 256) * 256 + eg * 16 : p->out + O_SC + ((size_t)((bi - 4) * 4 + h) * 256) * 256 + eg * 16;
    float* st = lds + 9000;
#pragma unroll
    for (int jj = 0; jj < 4; ++jj)
#pragma unroll
      for (int j4 = 0; j4 < 4; ++j4) st[(jj * 64 + l16 * 4 + j4) * 17 + grp] = C[jj * 4 + j4];
    __syncthreads();
#pragma unroll
    for (int i = 0; i < 4; ++i) {
      const float* d = st + ((tid >> 2) + 64 * i) * 17 + (tid & 3) * 4;
      *(float4*)(ob + (size_t)((tid >> 2) + 64 * i) * 256 + (tid & 3) * 4) = make_float4(d[0], d[1], d[2], d[3]);
    }
  } else {
    if (grp == 0) {
      float* ob = PROMPT ? p->out + O_PN + (size_t)(bi * 4 + h) * 256 : p->out + O_SN + (size_t)((bi - 4) * 4 + h) * 256;
#pragma unroll
      for (int jj = 0; jj < 4; ++jj)
#pragma unroll
        for (int j4 = 0; j4 < 4; ++j4) ob[jj * 64 + l16 * 4 + j4] = C[jj * 4 + j4];
    }
    if (tid == 0) {
      float* om = PROMPT ? p->out + O_PM + bi * 4 + h : p->out + O_SM + (bi - 4) * 4 + h;
      *om = smc[0];
    }
  }
}

template <bool PROMPT>
__device__ __forceinline__ void hgrn_unit(KP p, float* lds, int bi, int g, int vg) {
  constexpr int TC = PROMPT ? 16 : 8;
  constexpr int NCH = PROMPT ? 128 : 1;
  constexpr int NL = TC / 8;
  constexpr int INSZ = TC * 256 + TC * 32;
  const int tid = TID(), l16 = tid & 15, grp = tid >> 4;
  const int r0 = PROMPT ? bi * 2048 : NPR + (bi - 4) * 8;
  const float* Z = (const float*)(p->ws + W_Z);
  float* GO = (float*)(p->ws + W_GO);
  float* so = lds + 2 * INSZ;
  float S0[8], S1[8];
  const int v0 = vg * 32 + grp;
  if (!PROMPT) {
    const float* base = p->in[I_GS] + ((size_t)((bi - 4) * 8 + g) * 128) * 128 + vg * 32;
    float* st = lds + 5200;
    float4 sv4[4];
#pragma unroll
    for (int i = 0; i < 4; ++i) sv4[i] = *(const float4*)(base + (size_t)((tid >> 3) + 32 * i) * 128 + (tid & 7) * 4);
#pragma unroll
    for (int i = 0; i < 4; ++i) {
      float* d = st + ((tid >> 3) + 32 * i) * 33 + (tid & 7) * 4;
      d[0] = sv4[i].x; d[1] = sv4[i].y; d[2] = sv4[i].z; d[3] = sv4[i].w;
    }
    __syncthreads();
#pragma unroll
    for (int jj = 0; jj < 2; ++jj)
#pragma unroll
      for (int j4 = 0; j4 < 4; ++j4) {
        S0[jj * 4 + j4] = st[(jj * 64 + l16 * 4 + j4) * 33 + grp];
        S1[jj * 4 + j4] = st[(jj * 64 + l16 * 4 + j4) * 33 + grp + 16];
      }
  } else {
#pragma unroll
    for (int i = 0; i < 8; ++i) { S0[i] = 0.f; S1[i] = 0.f; }
  }
  float4 lb4;
  {
    const int cc = g * 128 + (tid & 31) * 4;
    const float4 l0 = *(const float4*)(p->in[I_GLB] + cc);
    const float4 l1 = *(const float4*)(p->in[I_GLB] + 1024 + cc);
    lb4.x = 1.f / (1.f + __expf(l1.x - l0.x)); lb4.y = 1.f / (1.f + __expf(l1.y - l0.y));
    lb4.z = 1.f / (1.f + __expf(l1.z - l0.z)); lb4.w = 1.f / (1.f + __expf(l1.w - l0.w));
  }
  constexpr int KD = PROMPT ? 4 : 1;
  float4 pgqa_0, pgqa_1, pgqa_2, pgqa_3, pgqb_0, pgqb_1, pgqb_2, pgqb_3, pgfa_0, pgfa_1, pgfa_2, pgfa_3, pgfb_0, pgfb_1, pgfb_2, pgfb_3;
  float pva_0 = 0.f, pva_1 = 0.f, pva_2 = 0.f, pva_3 = 0.f, pvb_0 = 0.f, pvb_1 = 0.f, pvb_2 = 0.f, pvb_3 = 0.f;
  pgqb_0 = pgqb_1 = pgqb_2 = pgqb_3 = pgfb_0 = pgfb_1 = pgfb_2 = pgfb_3 = make_float4(0, 0, 0, 0);
#define HG_GLOAD(j, c)                                                                                               \
  {                                                                                                                  \
    const int rowb = r0 + (c) * TC;                                                                                  \
    { const int idx = tid;                                                                                           \
      const float* zr = Z + (size_t)(rowb + (idx >> 5)) * INW + g * 128 + (idx & 31) * 4;                            \
      pgqa_##j = *(const float4*)(zr + 4104); pgfa_##j = *(const float4*)(zr + 5128);                                \
      pva_##j = Z[(size_t)(rowb + (idx >> 5)) * INW + 6152 + g * 128 + vg * 32 + (idx & 31)]; }                      \
    if (NL > 1) { const int idx = tid + 256;                                                                         \
      const float* zr = Z + (size_t)(rowb + (idx >> 5)) * INW + g * 128 + (idx & 31) * 4;                            \
      pgqb_##j = *(const float4*)(zr + 4104); pgfb_##j = *(const float4*)(zr + 5128);                                \
      pvb_##j = Z[(size_t)(rowb + (idx >> 5)) * INW + 6152 + g * 128 + vg * 32 + (idx & 31)]; }                      \
  }
  HG_GLOAD(0, 0);
  if constexpr (KD > 1) { HG_GLOAD(1, 1); HG_GLOAD(2, 2); HG_GLOAD(3, 3); }
#define HG_BODY(j) { \
    const int c = c0 + j; \
    const int b = j & 1; \
    float* in = lds + b * INSZ; \
    const float sc = 0.08838834764831845f; \
    { const int idx = tid; float4 q, f; \
      q.x = siluf_(pgqa_##j.x) * sc; q.y = siluf_(pgqa_##j.y) * sc; q.z = siluf_(pgqa_##j.z) * sc; q.w = siluf_(pgqa_##j.w) * sc; \
      f.x = lb4.x + (1.f - lb4.x) * sigmoidf_(pgfa_##j.x); f.y = lb4.y + (1.f - lb4.y) * sigmoidf_(pgfa_##j.y); \
      f.z = lb4.z + (1.f - lb4.z) * sigmoidf_(pgfa_##j.z); f.w = lb4.w + (1.f - lb4.w) * sigmoidf_(pgfa_##j.w); \
      *(float4*)(in + idx * 4) = q; *(float4*)(in + TC * 128 + idx * 4) = f; in[TC * 256 + idx] = pva_##j; } \
    if (NL > 1) { const int idx = tid + 256; float4 q, f; \
      q.x = siluf_(pgqb_##j.x) * sc; q.y = siluf_(pgqb_##j.y) * sc; q.z = siluf_(pgqb_##j.z) * sc; q.w = siluf_(pgqb_##j.w) * sc; \
      f.x = lb4.x + (1.f - lb4.x) * sigmoidf_(pgfb_##j.x); f.y = lb4.y + (1.f - lb4.y) * sigmoidf_(pgfb_##j.y); \
      f.z = lb4.z + (1.f - lb4.z) * sigmoidf_(pgfb_##j.z); f.w = lb4.w + (1.f - lb4.w) * sigmoidf_(pgfb_##j.w); \
      *(float4*)(in + idx * 4) = q; *(float4*)(in + TC * 128 + idx * 4) = f; in[TC * 256 + idx] = pvb_##j; } \
    LDS_BARRIER(); \
    if (c + KD < NCH) HG_GLOAD(j, c + KD); \
    if (c > 0) { \
      const int pb = b ^ 1, rowb = r0 + (c - 1) * TC; \
_Pragma("unroll") \
      for (int i = 0; i < NL; ++i) { \
        const int idx = tid + 256 * i; \
        GO[(size_t)(rowb + (idx >> 5)) * 1024 + g * 128 + vg * 32 + (idx & 31)] = so[pb * TC * 32 + idx]; \
      } \
    } \
    { float4 Aq0, Aq1, Af0, Af1, Bq0, Bq1, Bf0, Bf1; float Ava, Avb, Bva, Bvb; \
    HG_LD(A, 0) \
    HG_LD(B, 1) \
    HG_CP(A, 0) \
    HG_LD(A, 2) \
    HG_CP(B, 1) \
    HG_LD(B, 3) \
    HG_CP(A, 2) \
    HG_LD(A, 4) \
    HG_CP(B, 3) \
    HG_LD(B, 5) \
    HG_CP(A, 4) \
    HG_LD(A, 6) \
    HG_CP(B, 5) \
    HG_LD(B, 7) \
    HG_CP(A, 6) \
    if constexpr (TC == 16) { HG_LD(A, 8) } \
    HG_CP(B, 7) \
    if constexpr (TC == 16) { \
    HG_LD(B, 9) \
    HG_CP(A, 8) \
    HG_LD(A, 10) \
    HG_CP(B, 9) \
    HG_LD(B, 11) \
    HG_CP(A, 10) \
    HG_LD(A, 12) \
    HG_CP(B, 11) \
    HG_LD(B, 13) \
    HG_CP(A, 12) \
    HG_LD(A, 14) \
    HG_CP(B, 13) \
    HG_LD(B, 15) \
    HG_CP(A, 14) \
    HG_CP(B, 15) \
    } \
    } \
  }
#pragma unroll 1
  for (int c0 = 0; c0 < NCH; c0 += KD) {
    HG_BODY(0)
    if constexpr (KD > 1) { HG_BODY(1) HG_BODY(2) HG_BODY(3) }
  }
#undef HG_BODY
#undef HG_GLOAD
  __syncthreads();
  {
    const int pb = (NCH - 1) & 1, rowb = r0 + (NCH - 1) * TC;
#pragma unroll
    for (int i = 0; i < NL; ++i) {
      const int idx = tid + 256 * i;
      GO[(size_t)(rowb + (idx >> 5)) * 1024 + g * 128 + vg * 32 + (idx & 31)] = so[pb * TC * 32 + idx];
    }
  }
  float* ob = PROMPT ? p->out + O_PS + ((size_t)(bi * 8 + g) * 128) * 128 + vg * 32 : p->out + O_SS + ((size_t)((bi - 4) * 8 + g) * 128) * 128 + vg * 32;
  {
    float* st = lds + 5200 + (PROMPT ? 5500 : 0);
#pragma unroll
    for (int jj = 0; jj < 2; ++jj)
#pragma unroll
      for (int j4 = 0; j4 < 4; ++j4) {
        st[(jj * 64 + l16 * 4 + j4) * 33 + grp] = S0[jj * 4 + j4];
        st[(jj * 64 + l16 * 4 + j4) * 33 + grp + 16] = S1[jj * 4 + j4];
      }
    __syncthreads();
#pragma unroll
    for (int i = 0; i < 4; ++i) {
      const float* d = st + ((tid >> 3) + 32 * i) * 33 + (tid & 7) * 4;
      *(float4*)(ob + (size_t)((tid >> 3) + 32 * i) * 128 + (tid & 7) * 4) = make_float4(d[0], d[1], d[2], d[3]);
    }
  }
}

template <bool PROMPT>
__device__ __forceinline__ void rwkv_unit(KP p, float* lds, int bi, int h, int ig) {
  constexpr int TC = PROMPT ? 16 : 8;
  constexpr int NCH = PROMPT ? 128 : 1;
  constexpr int NV = TC / 8;
  constexpr int INSZ = TC * 64 * 5 + TC * 32;
  const int tid = TID(), l16 = tid & 15, grp = tid >> 4;
  const int r0 = PROMPT ? bi * 2048 : NPR + (bi - 4) * 8;
  const float* R = (const float*)(p->ws + W_R);
  const float* Kb = (const float*)(p->ws + W_K);
  const float* V = (const float*)(p->ws + W_V);
  const float* WP = (const float*)(p->ws + W_WP);
  const float* AP = (const float*)(p->ws + W_AP);
  float* Y = (float*)(p->ws + W_Y);
  float* so = lds + 2 * INSZ;
  const int irow = ig * 32 + grp;
  float4 S0, S1;
  if (!PROMPT) {
    const float* sb_ = p->in[I_RS] + ((size_t)((bi - 4) * 32 + h) * 64 + irow) * 64 + l16 * 4;
    S0 = *(const float4*)sb_;
    S1 = *(const float4*)(sb_ + 16 * 64);
  } else { S0 = make_float4(0, 0, 0, 0); S1 = S0; }
  const int cch = h * 64 + l16 * 4;
  const float4 w0 = *(const float4*)(p->in[I_RW0] + cch);
  const float4 a0 = *(const float4*)(p->in[I_RA0] + cch);
  const float4 kkw = *(const float4*)(p->in[I_RKK] + cch);
  const float4 kaw = *(const float4*)(p->in[I_RKA] + cch);
  const bool ldr = (grp < TC);
  constexpr int KD = PROMPT ? 4 : 1;
  float4 prr_0, prr_1, prr_2, prr_3, pkk_0, pkk_1, pkk_2, pkk_3, pww_0, pww_1, pww_2, pww_3, paa_0, paa_1, paa_2, paa_3;
  float pva_0 = 0.f, pva_1 = 0.f, pva_2 = 0.f, pva_3 = 0.f, pvb_0 = 0.f, pvb_1 = 0.f, pvb_2 = 0.f, pvb_3 = 0.f;
#define RW_GLOAD(j, c)                                                                                               \
  {                                                                                                                  \
    const int rowb = r0 + (c) * TC;                                                                                  \
    prr_##j = make_float4(0, 0, 0, 0); pkk_##j = prr_##j; pww_##j = prr_##j; paa_##j = prr_##j;                      \
    if (ldr) {                                                                                                       \
      const size_t ro = (size_t)(rowb + grp) * D + cch;                                                              \
      prr_##j = *(const float4*)(R + ro); pkk_##j = *(const float4*)(Kb + ro);                                       \
      pww_##j = *(const float4*)(WP + ro); paa_##j = *(const float4*)(AP + ro);                                      \
    }                                                                                                                \
    pva_##j = V[(size_t)(rowb + (tid >> 5)) * D + h * 64 + ig * 32 + (tid & 31)];                                    \
    if (NV > 1) pvb_##j = V[(size_t)(rowb + ((tid + 256) >> 5)) * D + h * 64 + ig * 32 + (tid & 31)];               \
  }
  RW_GLOAD(0, 0);
  if constexpr (KD > 1) { RW_GLOAD(1, 1); RW_GLOAD(2, 2); RW_GLOAD(3, 3); }
#define RW_BODY(j) { \
    const int c = c0 + j; \
    const int b = j & 1; \
    float* in = lds + b * INSZ; \
    const float4 pr = prr_##j, pk = pkk_##j, pw = pww_##j, pa = paa_##j; \
    if (ldr) { \
      float4 wp = pw; \
      wp.x += w0.x; wp.y += w0.y; wp.z += w0.z; wp.w += w0.w; \
      float4 kk; kk.x = pk.x * kkw.x; kk.y = pk.y * kkw.y; kk.z = pk.z * kkw.z; kk.w = pk.w * kkw.w; \
      float ss = kk.x * kk.x + kk.y * kk.y + kk.z * kk.z + kk.w * kk.w; \
      ss = row_sum16(ss); \
      const float inv = 1.f / fmaxf(sqrtf(ss), 1e-12f); \
      kk.x *= inv; kk.y *= inv; kk.z *= inv; kk.w *= inv; \
      float4 a; a.x = sigmoidf_(pa.x + a0.x); a.y = sigmoidf_(pa.y + a0.y); a.z = sigmoidf_(pa.z + a0.z); a.w = sigmoidf_(pa.w + a0.w); \
      float4 dw; \
      dw.x = __expf(-__expf(logsigmoidf_(wp.x) - 0.5f)); dw.y = __expf(-__expf(logsigmoidf_(wp.y) - 0.5f)); \
      dw.z = __expf(-__expf(logsigmoidf_(wp.z) - 0.5f)); dw.w = __expf(-__expf(logsigmoidf_(wp.w) - 0.5f)); \
      float4 kp; \
      kp.x = pk.x * (1.f + (a.x - 1.f) * kaw.x); kp.y = pk.y * (1.f + (a.y - 1.f) * kaw.y); \
      kp.z = pk.z * (1.f + (a.z - 1.f) * kaw.z); kp.w = pk.w * (1.f + (a.w - 1.f) * kaw.w); \
      const int o = grp * 64 + l16 * 4; \
      *(float4*)(in + o) = dw; \
      *(float4*)(in + TC * 64 + o) = make_float4(-kk.x, -kk.y, -kk.z, -kk.w); \
      *(float4*)(in + TC * 128 + o) = make_float4(kk.x * a.x, kk.y * a.y, kk.z * a.z, kk.w * a.w); \
      *(float4*)(in + TC * 192 + o) = kp; \
      *(float4*)(in + TC * 256 + o) = pr; \
    } \
    in[TC * 320 + tid] = pva_##j; if (NV > 1) in[TC * 320 + tid + 256] = pvb_##j; \
    LDS_BARRIER(); \
    if (c + KD < NCH) RW_GLOAD(j, c + KD); \
    if (c > 0) { \
      const int pb = b ^ 1, rowb = r0 + (c - 1) * TC; \
_Pragma("unroll") \
      for (int i = 0; i < NV; ++i) { \
        const int idx = tid + 256 * i; \
        Y[(size_t)(rowb + (idx >> 5)) * D + h * 64 + ig * 32 + (idx & 31)] = so[pb * TC * 32 + idx]; \
      } \
    } \
    { float4 Aw, Aa, Ab, Ak, Ar, Bw, Ba, Bb, Bk, Br; float Ava, Avb, Bva, Bvb; \
    RW_LD(A, 0) \
    RW_LD(B, 1) \
    RW_CP(A, 0) \
    RW_LD(A, 2) \
    RW_CP(B, 1) \
    RW_LD(B, 3) \
    RW_CP(A, 2) \
    RW_LD(A, 4) \
    RW_CP(B, 3) \
    RW_LD(B, 5) \
    RW_CP(A, 4) \
    RW_LD(A, 6) \
    RW_CP(B, 5) \
    RW_LD(B, 7) \
    RW_CP(A, 6) \
    if constexpr (TC == 16) { RW_LD(A, 8) } \
    RW_CP(B, 7) \
    if constexpr (TC == 16) { \
    RW_LD(B, 9) \
    RW_CP(A, 8) \
    RW_LD(A, 10) \
    RW_CP(B, 9) \
    RW_LD(B, 11) \
    RW_CP(A, 10) \
    RW_LD(A, 12) \
    RW_CP(B, 11) \
    RW_LD(B, 13) \
    RW_CP(A, 12) \
    RW_LD(A, 14) \
    RW_CP(B, 13) \
    RW_LD(B, 15) \
    RW_CP(A, 14) \
    RW_CP(B, 15) \
    } \
    } \
  }
#pragma unroll 1
  for (int c0 = 0; c0 < NCH; c0 += KD) {
    RW_BODY(0)
    if constexpr (KD > 1) { RW_BODY(1) RW_BODY(2) RW_BODY(3) }
  }
#undef RW_BODY
#undef RW_GLOAD
  __syncthreads();
  {
    const int pb = (NCH - 1) & 1, rowb = r0 + (NCH - 1) * TC;
#pragma unroll
    for (int i = 0; i < NV; ++i) {
      const int idx = tid + 256 * i;
      Y[(size_t)(rowb + (idx >> 5)) * D + h * 64 + ig * 32 + (idx & 31)] = so[pb * TC * 32 + idx];
    }
  }
  float* ob = PROMPT ? p->out + O_PRS + ((size_t)(bi * 32 + h) * 64 + irow) * 64 + l16 * 4
                     : p->out + O_SRS + ((size_t)((bi - 4) * 32 + h) * 64 + irow) * 64 + l16 * 4;
  *(float4*)ob = S0;
  *(float4*)(ob + 16 * 64) = S1;
}


__device__ __forceinline__ void ph_p0(KP p) {
  asm volatile("" : "+s"(p));
  char* lds = g_lds;
  int* s_unit = (int*)(g_lds + LDS_BYTES + 16);
  float* red = (float*)(g_lds + LDS_BYTES + 32);
  unsigned* ctr = (unsigned*)(p->ws + W_BAR) + 8192;
  const int tid = TID();
  const int G = gridDim.x;
  const int gtid = blockIdx.x * 256 + tid, gthreads = G * 256;
  u16* SCB = (u16*)(p->ws + W_SCB);
  float* MOD = (float*)(p->ws + W_MOD);
  u16* HA = (u16*)(p->ws + W_HA);
  u16* MIXED = (u16*)(p->ws + W_MIXED);
  float* X1 = (float*)(p->ws + W_X1);
  float* X2 = (float*)(p->ws + W_X2);
  float* Z = (float*)(p->ws + W_Z);
  float* QK = (float*)(p->ws + W_QK);
  u16* ACT = (u16*)(p->ws + W_ACT);
  u16* XMIX = (u16*)(p->ws + W_XMIX);
  (void)lds; (void)s_unit; (void)red; (void)ctr; (void)tid; (void)G; (void)gtid; (void)gthreads; (void)SCB; (void)MOD; (void)HA; (void)MIXED;
  (void)X1; (void)X2; (void)Z; (void)QK; (void)ACT; (void)XMIX;
  for (int i = gtid; i < 256 * D; i += gthreads) {
    const int r = i >> 11, c = i & 2047;
    float v = 0.f;
    if (r < 4) v = siluf_(p->in[I_CP][r * D + c]);
    else if (r < NB) v = siluf_(p->in[I_CS][(r - 4) * D + c]);
    SCB[i] = f2bf(v);
  }
  {
    u16* WT = (u16*)(p->ws + W_WT);
    int rot = 0;
    transpose_job(p->in[I_WIN], D, INW, WT + T_WIN, D, 8320, rot); rot += 32 * 130;
    transpose_job(p->in[I_WOUT], D, D, WT + T_WOUT, D, D, rot); rot += 1024;
    transpose_job(p->in[I_W1], D, DFF, WT + T_W1, D, DFF, rot); rot += 4096;
    if (G <= 256) transpose_job(p->in[I_W1] + (size_t)D * DFF, D, DFF, WT + T_W1 + (size_t)D * DFF, D, DFF, rot);
    rot += 4096;
    transpose_job(p->in[I_W2], DFF, D, WT + T_W2, DFF, D, rot); rot += 4096;
    if (G <= 256) transpose_job(p->in[I_W2] + (size_t)D * DFF, DFF, D, WT + T_W2 + (size_t)D * DFF, DFF, D, rot);
    rot += 4096;
    transpose_job(p->in[I_WR], D, D, WT + T_WR, D, D, rot); rot += 1024;
    transpose_job(p->in[I_WK], D, D, WT + T_WK, D, D, rot); rot += 1024;
    transpose_job(p->in[I_WV], D, D, WT + T_WV, D, D, rot); rot += 1024;
    transpose_job(p->in[I_WO], D, D, WT + T_WO, D, D, rot); rot += 1024;
    transpose_job(p->in[I_RW1], D, 96, WT + T_RW1, D, 128, rot); rot += 64;
    transpose_job(p->in[I_RA1], D, 96, WT + T_RA1, D, 128, rot); rot += 64;
    transpose_job(p->in[I_RG1], D, 256, WT + T_RG1, D, 256, rot); rot += 128;
    transpose_job(p->in[I_RW2], 96, D, WT + T_RW2, 128, D, rot); rot += 64;
    transpose_job(p->in[I_RA2], 96, D, WT + T_RA2, 128, D, rot); rot += 64;
    transpose_job(p->in[I_RG2], 256, D, WT + T_RG2, 256, D, rot);
  }
}

__device__ __forceinline__ void ph_p1(KP p) {
  asm volatile("" : "+s"(p));
  char* lds = g_lds;
  int* s_unit = (int*)(g_lds + LDS_BYTES + 16);
  float* red = (float*)(g_lds + LDS_BYTES + 32);
  unsigned* ctr = (unsigned*)(p->ws + W_BAR) + 8192;
  const int tid = TID();
  const int G = gridDim.x;
  const int gtid = blockIdx.x * 256 + tid, gthreads = G * 256;
  u16* SCB = (u16*)(p->ws + W_SCB);
  float* MOD = (float*)(p->ws + W_MOD);
  u16* HA = (u16*)(p->ws + W_HA);
  u16* MIXED = (u16*)(p->ws + W_MIXED);
  float* X1 = (float*)(p->ws + W_X1);
  float* X2 = (float*)(p->ws + W_X2);
  float* Z = (float*)(p->ws + W_Z);
  float* QK = (float*)(p->ws + W_QK);
  u16* ACT = (u16*)(p->ws + W_ACT);
  u16* XMIX = (u16*)(p->ws + W_XMIX);
  (void)lds; (void)s_unit; (void)red; (void)ctr; (void)tid; (void)G; (void)gtid; (void)gthreads; (void)SCB; (void)MOD; (void)HA; (void)MIXED;
  (void)X1; (void)X2; (void)Z; (void)QK; (void)ACT; (void)XMIX;
  for (int l = 0; l < 2; ++l) {
    float* mo = MOD + (size_t)l * NB * 12288;
    const float* bias = p->in[I_MODB] + (size_t)l * 12288;
    gemm_job(lds, SCB, D, p->in[I_MODW] + (size_t)l * D * 12288, 12288, 2, 12288, D, l * 192,
             EPI_ELEM(if (row < NB) mo[(unsigned)row * 12288 + col] = v + bias[col];));
  }
}

__device__ __forceinline__ void ph_norm0(KP p) {
  asm volatile("" : "+s"(p));
  char* lds = g_lds;
  int* s_unit = (int*)(g_lds + LDS_BYTES + 16);
  float* red = (float*)(g_lds + LDS_BYTES + 32);
  unsigned* ctr = (unsigned*)(p->ws + W_BAR) + 8192;
  const int tid = TID();
  const int G = gridDim.x;
  const int gtid = blockIdx.x * 256 + tid, gthreads = G * 256;
  u16* SCB = (u16*)(p->ws + W_SCB);
  float* MOD = (float*)(p->ws + W_MOD);
  u16* HA = (u16*)(p->ws + W_HA);
  u16* MIXED = (u16*)(p->ws + W_MIXED);
  float* X1 = (float*)(p->ws + W_X1);
  float* X2 = (float*)(p->ws + W_X2);
  float* Z = (float*)(p->ws + W_Z);
  float* QK = (float*)(p->ws + W_QK);
  u16* ACT = (u16*)(p->ws + W_ACT);
  u16* XMIX = (u16*)(p->ws + W_XMIX);
  (void)lds; (void)s_unit; (void)red; (void)ctr; (void)tid; (void)G; (void)gtid; (void)gthreads; (void)SCB; (void)MOD; (void)HA; (void)MIXED;
  (void)X1; (void)X2; (void)Z; (void)QK; (void)ACT; (void)XMIX;
  norm_pass<0>(p, red, [&](int r) { return xin_row(p, r); }, p->in[I_NMIX], 0, 0);
}

__device__ __forceinline__ void ph_p3(KP p) {
  asm volatile("" : "+s"(p));
  char* lds = g_lds;
  int* s_unit = (int*)(g_lds + LDS_BYTES + 16);
  float* red = (float*)(g_lds + LDS_BYTES + 32);
  unsigned* ctr = (unsigned*)(p->ws + W_BAR) + 8192;
  const int tid = TID();
  const int G = gridDim.x;
  const int gtid = blockIdx.x * 256 + tid, gthreads = G * 256;
  u16* SCB = (u16*)(p->ws + W_SCB);
  float* MOD = (float*)(p->ws + W_MOD);
  u16* HA = (u16*)(p->ws + W_HA);
  u16* MIXED = (u16*)(p->ws + W_MIXED);
  float* X1 = (float*)(p->ws + W_X1);
  float* X2 = (float*)(p->ws + W_X2);
  float* Z = (float*)(p->ws + W_Z);
  float* QK = (float*)(p->ws + W_QK);
  u16* ACT = (u16*)(p->ws + W_ACT);
  u16* XMIX = (u16*)(p->ws + W_XMIX);
  (void)lds; (void)s_unit; (void)red; (void)ctr; (void)tid; (void)G; (void)gtid; (void)gthreads; (void)SCB; (void)MOD; (void)HA; (void)MIXED;
  (void)X1; (void)X2; (void)Z; (void)QK; (void)ACT; (void)XMIX;
  gemm2_job(HA, D, (const u16*)(p->ws + W_WT) + T_WIN, D, 72, 65, INW, D, 0,
           EPI_ELEM(Z[(unsigned)row * INW + col] = v;));
}

__device__ __forceinline__ void ph_p4(KP p) {
  asm volatile("" : "+s"(p));
  char* lds = g_lds;
  int* s_unit = (int*)(g_lds + LDS_BYTES + 16);
  float* red = (float*)(g_lds + LDS_BYTES + 32);
  unsigned* ctr = (unsigned*)(p->ws + W_BAR) + 8192;
  const int tid = TID();
  const int G = gridDim.x;
  const int gtid = blockIdx.x * 256 + tid, gthreads = G * 256;
  u16* SCB = (u16*)(p->ws + W_SCB);
  float* MOD = (float*)(p->ws + W_MOD);
  u16* HA = (u16*)(p->ws + W_HA);
  u16* MIXED = (u16*)(p->ws + W_MIXED);
  float* X1 = (float*)(p->ws + W_X1);
  float* X2 = (float*)(p->ws + W_X2);
  float* Z = (float*)(p->ws + W_Z);
  float* QK = (float*)(p->ws + W_QK);
  u16* ACT = (u16*)(p->ws + W_ACT);
  u16* XMIX = (u16*)(p->ws + W_XMIX);
  (void)lds; (void)s_unit; (void)red; (void)ctr; (void)tid; (void)G; (void)gtid; (void)gthreads; (void)SCB; (void)MOD; (void)HA; (void)MIXED;
  (void)X1; (void)X2; (void)Z; (void)QK; (void)ACT; (void)XMIX;
  {
    const float* cw = p->in[I_CONVW];
    for (int i = gtid; i < (NTOK / 4) * 512; i += gthreads) {
      const int r0 = (i >> 9) * 4, c = (i & 511) * 4;
      int bi, t0, T;
      row_info(r0, bi, t0, T);
      float4 u[7];
#pragma unroll
      for (int j = 0; j < 7; ++j) {
        const int tt = t0 - 3 + j;
        if (tt >= 0) u[j] = *(const float4*)(Z + (size_t)(r0 - 3 + j) * INW + c);
        else if (bi >= 4) u[j] = *(const float4*)(p->in[I_MCONV] + ((size_t)(bi - 4) * 3 + (tt + 3)) * D + c);
        else u[j] = make_float4(0, 0, 0, 0);
      }
      float4 wv[4];
#pragma unroll
      for (int j = 0; j < 4; ++j) wv[j] = *(const float4*)(cw + j * D + c);
      const float s = (c >= 1024) ? 0.0625f : 1.f;
#pragma unroll
      for (int q = 0; q < 4; ++q) {
        float4 acc = make_float4(0, 0, 0, 0);
#pragma unroll
        for (int j = 0; j < 4; ++j) {
          acc.x += u[q + j].x * wv[j].x; acc.y += u[q + j].y * wv[j].y; acc.z += u[q + j].z * wv[j].z; acc.w += u[q + j].w * wv[j].w;
        }
        float4 o;
        o.x = siluf_(acc.x) * s; o.y = siluf_(acc.y) * s; o.z = siluf_(acc.z) * s; o.w = siluf_(acc.w) * s;
        *(float4*)(QK + (size_t)(r0 + q) * D + c) = o;
        const int t = t0 + q;
        if (t >= T - 3) {
          float* co = (bi < 4) ? p->out + O_PCONV + ((size_t)bi * 3 + (t - (T - 3))) * D + c
                               : p->out + O_SCONV + ((size_t)(bi - 4) * 3 + (t - (T - 3))) * D + c;
          *(float4*)co = u[q + 3];
        }
      }
    }
  }
}

__device__ __forceinline__ void ph_p5(KP p) {
  asm volatile("" : "+s"(p));
  char* lds = g_lds;
  int* s_unit = (int*)(g_lds + LDS_BYTES + 16);
  float* red = (float*)(g_lds + LDS_BYTES + 32);
  unsigned* ctr = (unsigned*)(p->ws + W_BAR) + 8192;
  const int tid = TID();
  const int G = gridDim.x;
  const int gtid = blockIdx.x * 256 + tid, gthreads = G * 256;
  u16* SCB = (u16*)(p->ws + W_SCB);
  float* MOD = (float*)(p->ws + W_MOD);
  u16* HA = (u16*)(p->ws + W_HA);
  u16* MIXED = (u16*)(p->ws + W_MIXED);
  float* X1 = (float*)(p->ws + W_X1);
  float* X2 = (float*)(p->ws + W_X2);
  float* Z = (float*)(p->ws + W_Z);
  float* QK = (float*)(p->ws + W_QK);
  u16* ACT = (u16*)(p->ws + W_ACT);
  u16* XMIX = (u16*)(p->ws + W_XMIX);
  (void)lds; (void)s_unit; (void)red; (void)ctr; (void)tid; (void)G; (void)gtid; (void)gthreads; (void)SCB; (void)MOD; (void)HA; (void)MIXED;
  (void)X1; (void)X2; (void)Z; (void)QK; (void)ACT; (void)XMIX;
  if (blockIdx.x < 256) {
    for (;;) {
      const int u = next_unit(ctr + 0, s_unit);
      if (u >= 256) break;
      mlstm_unit<true>(p, (float*)lds, u >> 6, (u >> 4) & 3, u & 15);
    }
  }
  for (;;) {
    const int u = next_unit(ctr + 16, s_unit);
    if (u >= 144) break;
    if (u < 16) mlstm_unit<true>(p, (float*)lds, u >> 2, u & 3, 16);
    else { const int v = u - 16; hgrn_unit<true>(p, (float*)lds, v >> 5, (v & 31) >> 2, v & 3); }
  }
  for (;;) {
    const int v = next_unit(ctr + 32, s_unit);
    if (v >= 12800) break;
    if (v < 8704) mlstm_unit<false>(p, (float*)lds, 4 + v / 68, (v % 68) / 17, v % 17);
    else { const int w = v - 8704; hgrn_unit<false>(p, (float*)lds, 4 + (w >> 5), (w & 31) >> 2, w & 3); }
  }
}

__device__ __forceinline__ void ph_p6(KP p) {
  asm volatile("" : "+s"(p));
  char* lds = g_lds;
  int* s_unit = (int*)(g_lds + LDS_BYTES + 16);
  float* red = (float*)(g_lds + LDS_BYTES + 32);
  unsigned* ctr = (unsigned*)(p->ws + W_BAR) + 8192;
  const int tid = TID();
  const int G = gridDim.x;
  const int gtid = blockIdx.x * 256 + tid, gthreads = G * 256;
  u16* SCB = (u16*)(p->ws + W_SCB);
  float* MOD = (float*)(p->ws + W_MOD);
  u16* HA = (u16*)(p->ws + W_HA);
  u16* MIXED = (u16*)(p->ws + W_MIXED);
  float* X1 = (float*)(p->ws + W_X1);
  float* X2 = (float*)(p->ws + W_X2);
  float* Z = (float*)(p->ws + W_Z);
  float* QK = (float*)(p->ws + W_QK);
  u16* ACT = (u16*)(p->ws + W_ACT);
  u16* XMIX = (u16*)(p->ws + W_XMIX);
  (void)lds; (void)s_unit; (void)red; (void)ctr; (void)tid; (void)G; (void)gtid; (void)gthreads; (void)SCB; (void)MOD; (void)HA; (void)MIXED;
  (void)X1; (void)X2; (void)Z; (void)QK; (void)ACT; (void)XMIX;
  {
    const int lane = tid & 63;
    const int gw = blockIdx.x * 4 + (tid >> 6), nw = G * 4;
    const float* MO = (const float*)(p->ws + W_MO);
    const float* GO = (const float*)(p->ws + W_GO);
    const float* DEN = (const float*)(p->ws + W_DEN);
    const float* MST = (const float*)(p->ws + W_MST);
    for (int task = gw; task < NTOK * 2; task += nw) {
      const int r = task >> 1;
      const float* zr = Z + (size_t)r * INW;
      if ((task & 1) == 0) {
        float4 nv[4], mo[4];
        float den[4], ms[4];
#pragma unroll
        for (int hh = 0; hh < 4; ++hh) {
          const int c = hh * 256 + lane * 4;
          nv[hh] = *(const float4*)(MO + (size_t)r * 1024 + c);
          mo[hh] = *(const float4*)(zr + 3072 + c);
          den[hh] = DEN[(size_t)r * 4 + hh]; ms[hh] = MST[(size_t)r * 4 + hh];
        }
#pragma unroll
        for (int hh = 0; hh < 4; ++hh) {
          const int c = hh * 256 + lane * 4;
          float4 n4 = nv[hh];
          const float inv = 1.f / fmaxf(fabsf(den[hh]), __expf(-ms[hh]));
          n4.x *= inv; n4.y *= inv; n4.z *= inv; n4.w *= inv;
          const float mean = wave_sum(n4.x + n4.y + n4.z + n4.w) * (1.f / 256.f);
          n4.x -= mean; n4.y -= mean; n4.z -= mean; n4.w -= mean;
          const float var = wave_sum(n4.x * n4.x + n4.y * n4.y + n4.z * n4.z + n4.w * n4.w) * (1.f / 256.f);
          const float rs = rsqrtf(var + 1e-6f);
          const float4 gn = *(const float4*)(p->in[I_MNORM] + c);
          uint2 o;
          o.x = pack2(sigmoidf_(mo[hh].x) * n4.x * rs * gn.x, sigmoidf_(mo[hh].y) * n4.y * rs * gn.y);
          o.y = pack2(sigmoidf_(mo[hh].z) * n4.z * rs * gn.z, sigmoidf_(mo[hh].w) * n4.w * rs * gn.w);
          *(uint2*)(MIXED + (size_t)r * D + c) = o;
        }
      } else {
        float4 ov[4], gg[4];
#pragma unroll
        for (int q = 0; q < 4; ++q) {
          const int c = (q * 2 + (lane >> 5)) * 128 + (lane & 31) * 4;
          ov[q] = *(const float4*)(GO + (size_t)r * 1024 + c);
          gg[q] = *(const float4*)(zr + 7176 + c);
        }
#pragma unroll
        for (int q = 0; q < 4; ++q) {
          const int c = (q * 2 + (lane >> 5)) * 128 + (lane & 31) * 4;
          float ssq = ov[q].x * ov[q].x + ov[q].y * ov[q].y + ov[q].z * ov[q].z + ov[q].w * ov[q].w;
          ssq = row_sum16(ssq);
          ssq += __shfl_xor(ssq, 16);
          const float rs = rsqrtf(ssq * (1.f / 128.f) + 1e-6f);
          const float4 gn = *(const float4*)(p->in[I_GNORM] + c);
          uint2 o;
          o.x = pack2(ov[q].x * rs * gn.x * siluf_(gg[q].x), ov[q].y * rs * gn.y * siluf_(gg[q].y));
          o.y = pack2(ov[q].z * rs * gn.z * siluf_(gg[q].z), ov[q].w * rs * gn.w * siluf_(gg[q].w));
          *(uint2*)(MIXED + (size_t)r * D + 1024 + c) = o;
        }
      }
    }
  }
}

__device__ __forceinline__ void ph_p7(KP p) {
  asm volatile("" : "+s"(p));
  char* lds = g_lds;
  int* s_unit = (int*)(g_lds + LDS_BYTES + 16);
  float* red = (float*)(g_lds + LDS_BYTES + 32);
  unsigned* ctr = (unsigned*)(p->ws + W_BAR) + 8192;
  const int tid = TID();
  const int G = gridDim.x;
  const int gtid = blockIdx.x * 256 + tid, gthreads = G * 256;
  u16* SCB = (u16*)(p->ws + W_SCB);
  float* MOD = (float*)(p->ws + W_MOD);
  u16* HA = (u16*)(p->ws + W_HA);
  u16* MIXED = (u16*)(p->ws + W_MIXED);
  float* X1 = (float*)(p->ws + W_X1);
  float* X2 = (float*)(p->ws + W_X2);
  float* Z = (float*)(p->ws + W_Z);
  float* QK = (float*)(p->ws + W_QK);
  u16* ACT = (u16*)(p->ws + W_ACT);
  u16* XMIX = (u16*)(p->ws + W_XMIX);
  (void)lds; (void)s_unit; (void)red; (void)ctr; (void)tid; (void)G; (void)gtid; (void)gthreads; (void)SCB; (void)MOD; (void)HA; (void)MIXED;
  (void)X1; (void)X2; (void)Z; (void)QK; (void)ACT; (void)XMIX;
  {
    const float* mod = MOD;
    KP pp = p;
    gemm2_job(MIXED, D, (const u16*)(p->ws + W_WT) + T_WOUT, D, 72, 16, D, D, 0, EPI_RESID(X1, ((rb < NPR) ? pp->in[I_XP] : pp->in[I_XS] - (size_t)NPR * D), mod, 2));
  }
}

__device__ __forceinline__ void ph_norm1(KP p) {
  asm volatile("" : "+s"(p));
  char* lds = g_lds;
  int* s_unit = (int*)(g_lds + LDS_BYTES + 16);
  float* red = (float*)(g_lds + LDS_BYTES + 32);
  unsigned* ctr = (unsigned*)(p->ws + W_BAR) + 8192;
  const int tid = TID();
  const int G = gridDim.x;
  const int gtid = blockIdx.x * 256 + tid, gthreads = G * 256;
  u16* SCB = (u16*)(p->ws + W_SCB);
  float* MOD = (float*)(p->ws + W_MOD);
  u16* HA = (u16*)(p->ws + W_HA);
  u16* MIXED = (u16*)(p->ws + W_MIXED);
  float* X1 = (float*)(p->ws + W_X1);
  float* X2 = (float*)(p->ws + W_X2);
  float* Z = (float*)(p->ws + W_Z);
  float* QK = (float*)(p->ws + W_QK);
  u16* ACT = (u16*)(p->ws + W_ACT);
  u16* XMIX = (u16*)(p->ws + W_XMIX);
  (void)lds; (void)s_unit; (void)red; (void)ctr; (void)tid; (void)G; (void)gtid; (void)gthreads; (void)SCB; (void)MOD; (void)HA; (void)MIXED;
  (void)X1; (void)X2; (void)Z; (void)QK; (void)ACT; (void)XMIX;
  norm_pass<1>(p, red, [&](int r) { return (const float*)(X2 + (size_t)r * D); }, p->in[I_NMIX] + D, 1, 0);
}

__device__ __forceinline__ void ph_p12(KP p) {
  asm volatile("" : "+s"(p));
  char* lds = g_lds;
  int* s_unit = (int*)(g_lds + LDS_BYTES + 16);
  float* red = (float*)(g_lds + LDS_BYTES + 32);
  unsigned* ctr = (unsigned*)(p->ws + W_BAR) + 8192;
  const int tid = TID();
  const int G = gridDim.x;
  const int gtid = blockIdx.x * 256 + tid, gthreads = G * 256;
  u16* SCB = (u16*)(p->ws + W_SCB);
  float* MOD = (float*)(p->ws + W_MOD);
  u16* HA = (u16*)(p->ws + W_HA);
  u16* MIXED = (u16*)(p->ws + W_MIXED);
  float* X1 = (float*)(p->ws + W_X1);
  float* X2 = (float*)(p->ws + W_X2);
  float* Z = (float*)(p->ws + W_Z);
  float* QK = (float*)(p->ws + W_QK);
  u16* ACT = (u16*)(p->ws + W_ACT);
  u16* XMIX = (u16*)(p->ws + W_XMIX);
  (void)lds; (void)s_unit; (void)red; (void)ctr; (void)tid; (void)G; (void)gtid; (void)gthreads; (void)SCB; (void)MOD; (void)HA; (void)MIXED;
  (void)X1; (void)X2; (void)Z; (void)QK; (void)ACT; (void)XMIX;
      {
        float* R = (float*)(p->ws + W_R); float* Kb = (float*)(p->ws + W_K); float* V = (float*)(p->ws + W_V);
        u16* L1A = (u16*)(p->ws + W_L1A); u16* L1B = (u16*)(p->ws + W_L1B); u16* L1G = (u16*)(p->ws + W_L1G);
        const size_t XS = (size_t)NTOK * D;
        gemm2_job(XMIX + 0 * XS, D, (const u16*)(p->ws + W_WT) + T_WR, D, 72, 16, D, D, 0, EPI_ELEM(R[(unsigned)row * D + col] = v;));
        gemm2_job(XMIX + 2 * XS, D, (const u16*)(p->ws + W_WT) + T_WK, D, 72, 16, D, D, 1152, EPI_ELEM(Kb[(unsigned)row * D + col] = v;));
        gemm2_job(XMIX + 3 * XS, D, (const u16*)(p->ws + W_WT) + T_WV, D, 72, 16, D, D, 2304, EPI_ELEM(V[(unsigned)row * D + col] = v;));
        gemm2_job(XMIX + 1 * XS, D, (const u16*)(p->ws + W_WT) + T_RW1, D, 72, 1, 128, D, 3456, EPI_ELEM(L1A[(unsigned)row * 128 + col] = f2bf(tanhf(v));));
        gemm2_job(XMIX + 4 * XS, D, (const u16*)(p->ws + W_WT) + T_RA1, D, 72, 1, 128, D, 3528, EPI_ELEM(L1B[(unsigned)row * 128 + col] = f2bf(v);));
        gemm2_job(XMIX + 5 * XS, D, (const u16*)(p->ws + W_WT) + T_RG1, D, 72, 2, 256, D, 3600, EPI_ELEM(L1G[(unsigned)row * 256 + col] = f2bf(sigmoidf_(v));));
      }
}

__device__ __forceinline__ void ph_p13(KP p) {
  asm volatile("" : "+s"(p));
  char* lds = g_lds;
  int* s_unit = (int*)(g_lds + LDS_BYTES + 16);
  float* red = (float*)(g_lds + LDS_BYTES + 32);
  unsigned* ctr = (unsigned*)(p->ws + W_BAR) + 8192;
  const int tid = TID();
  const int G = gridDim.x;
  const int gtid = blockIdx.x * 256 + tid, gthreads = G * 256;
  u16* SCB = (u16*)(p->ws + W_SCB);
  float* MOD = (float*)(p->ws + W_MOD);
  u16* HA = (u16*)(p->ws + W_HA);
  u16* MIXED = (u16*)(p->ws + W_MIXED);
  float* X1 = (float*)(p->ws + W_X1);
  float* X2 = (float*)(p->ws + W_X2);
  float* Z = (float*)(p->ws + W_Z);
  float* QK = (float*)(p->ws + W_QK);
  u16* ACT = (u16*)(p->ws + W_ACT);
  u16* XMIX = (u16*)(p->ws + W_XMIX);
  (void)lds; (void)s_unit; (void)red; (void)ctr; (void)tid; (void)G; (void)gtid; (void)gthreads; (void)SCB; (void)MOD; (void)HA; (void)MIXED;
  (void)X1; (void)X2; (void)Z; (void)QK; (void)ACT; (void)XMIX;
      {
        float* WP = (float*)(p->ws + W_WP); float* AP = (float*)(p->ws + W_AP); float* Gt = (float*)(p->ws + W_G);
        gemm2_job((const u16*)(p->ws + W_L1A), 128, (const u16*)(p->ws + W_WT) + T_RW2, 128, 72, 16, D, 128, 0, EPI_ELEM(WP[(unsigned)row * D + col] = v;));
        gemm2_job((const u16*)(p->ws + W_L1B), 128, (const u16*)(p->ws + W_WT) + T_RA2, 128, 72, 16, D, 128, 1152, EPI_ELEM(AP[(unsigned)row * D + col] = v;));
        gemm2_job((const u16*)(p->ws + W_L1G), 256, (const u16*)(p->ws + W_WT) + T_RG2, 256, 72, 16, D, 256, 2304, EPI_ELEM(Gt[(unsigned)row * D + col] = v;));
      }
}

__device__ __forceinline__ void ph_p14(KP p) {
  asm volatile("" : "+s"(p));
  char* lds = g_lds;
  int* s_unit = (int*)(g_lds + LDS_BYTES + 16);
  float* red = (float*)(g_lds + LDS_BYTES + 32);
  unsigned* ctr = (unsigned*)(p->ws + W_BAR) + 8192;
  const int tid = TID();
  const int G = gridDim.x;
  const int gtid = blockIdx.x * 256 + tid, gthreads = G * 256;
  u16* SCB = (u16*)(p->ws + W_SCB);
  float* MOD = (float*)(p->ws + W_MOD);
  u16* HA = (u16*)(p->ws + W_HA);
  u16* MIXED = (u16*)(p->ws + W_MIXED);
  float* X1 = (float*)(p->ws + W_X1);
  float* X2 = (float*)(p->ws + W_X2);
  float* Z = (float*)(p->ws + W_Z);
  float* QK = (float*)(p->ws + W_QK);
  u16* ACT = (u16*)(p->ws + W_ACT);
  u16* XMIX = (u16*)(p->ws + W_XMIX);
  (void)lds; (void)s_unit; (void)red; (void)ctr; (void)tid; (void)G; (void)gtid; (void)gthreads; (void)SCB; (void)MOD; (void)HA; (void)MIXED;
  (void)X1; (void)X2; (void)Z; (void)QK; (void)ACT; (void)XMIX;
      if (blockIdx.x < 256) {
        for (;;) {
          const int u = next_unit(ctr + 64, s_unit);
          if (u >= 256) break;
          rwkv_unit<true>(p, (float*)lds, u >> 6, (u & 63) >> 1, u & 1);
        }
      }
      for (;;) {
        const int v = next_unit(ctr + 80, s_unit);
        if (v >= 8192) break;
        rwkv_unit<false>(p, (float*)lds, 4 + (v >> 6), (v & 63) >> 1, v & 1);
      }
      if (G > 256 && blockIdx.x >= 256) {
        u16* WT = (u16*)(p->ws + W_WT);
        __syncthreads();
        transpose_job(p->in[I_W1] + (size_t)D * DFF, D, DFF, WT + T_W1 + (size_t)D * DFF, D, DFF, 0, G - 256, (int)blockIdx.x - 256);
        transpose_job(p->in[I_W2] + (size_t)D * DFF, DFF, D, WT + T_W2 + (size_t)D * DFF, DFF, D, 0, G - 256, (int)blockIdx.x - 256);
      }
}

__device__ __forceinline__ void ph_p15(KP p) {
  asm volatile("" : "+s"(p));
  char* lds = g_lds;
  int* s_unit = (int*)(g_lds + LDS_BYTES + 16);
  float* red = (float*)(g_lds + LDS_BYTES + 32);
  unsigned* ctr = (unsigned*)(p->ws + W_BAR) + 8192;
  const int tid = TID();
  const int G = gridDim.x;
  const int gtid = blockIdx.x * 256 + tid, gthreads = G * 256;
  u16* SCB = (u16*)(p->ws + W_SCB);
  float* MOD = (float*)(p->ws + W_MOD);
  u16* HA = (u16*)(p->ws + W_HA);
  u16* MIXED = (u16*)(p->ws + W_MIXED);
  float* X1 = (float*)(p->ws + W_X1);
  float* X2 = (float*)(p->ws + W_X2);
  float* Z = (float*)(p->ws + W_Z);
  float* QK = (float*)(p->ws + W_QK);
  u16* ACT = (u16*)(p->ws + W_ACT);
  u16* XMIX = (u16*)(p->ws + W_XMIX);
  (void)lds; (void)s_unit; (void)red; (void)ctr; (void)tid; (void)G; (void)gtid; (void)gthreads; (void)SCB; (void)MOD; (void)HA; (void)MIXED;
  (void)X1; (void)X2; (void)Z; (void)QK; (void)ACT; (void)XMIX;
      {
        const int lane = tid & 63, l16 = lane & 15, hq = lane >> 4;
        const int gw = blockIdx.x * 4 + (tid >> 6), nw = G * 4;
        const float* R = (const float*)(p->ws + W_R); const float* Kb = (const float*)(p->ws + W_K); const float* V = (const float*)(p->ws + W_V);
        const float* AP = (const float*)(p->ws + W_AP); const float* Gt = (const float*)(p->ws + W_G); const float* Y = (const float*)(p->ws + W_Y);
        for (int task0 = gw; task0 < NTOK * 8; task0 += 2 * nw) {
          float4 y[2], ap[2], kb[2], rv[2], vv[2], gt[2];
          unsigned oo[2]; int cc[2]; bool ok[2];
#pragma unroll
          for (int u = 0; u < 2; ++u) {
            const int task = task0 + u * nw;
            ok[u] = task < NTOK * 8;
            const int tk = ok[u] ? task : gw;
            cc[u] = ((tk & 7) * 4 + hq) * 64 + l16 * 4;
            oo[u] = (unsigned)(tk >> 3) * D + cc[u];
            y[u] = *(const float4*)(Y + oo[u]); ap[u] = *(const float4*)(AP + oo[u]); kb[u] = *(const float4*)(Kb + oo[u]);
            rv[u] = *(const float4*)(R + oo[u]); vv[u] = *(const float4*)(V + oo[u]); gt[u] = *(const float4*)(Gt + oo[u]);
          }
#pragma unroll
          for (int u = 0; u < 2; ++u) {
            const int c = cc[u];
            const float4 lnw = *(const float4*)(p->in[I_LNW] + c), lnb = *(const float4*)(p->in[I_LNB] + c);
            const float4 a0 = *(const float4*)(p->in[I_RA0] + c), ka = *(const float4*)(p->in[I_RKA] + c), rrk = *(const float4*)(p->in[I_RRK] + c);
            float4 yy = y[u];
            const float mean = row_sum16(yy.x + yy.y + yy.z + yy.w) * (1.f / 64.f);
            yy.x -= mean; yy.y -= mean; yy.z -= mean; yy.w -= mean;
            const float var = row_sum16(yy.x * yy.x + yy.y * yy.y + yy.z * yy.z + yy.w * yy.w) * (1.f / 64.f);
            const float rs = rsqrtf(var + 64e-5f);
            yy.x = yy.x * rs * lnw.x + lnb.x; yy.y = yy.y * rs * lnw.y + lnb.y; yy.z = yy.z * rs * lnw.z + lnb.z; yy.w = yy.w * rs * lnw.w + lnb.w;
            float4 kp;
            kp.x = kb[u].x * (1.f + (sigmoidf_(ap[u].x + a0.x) - 1.f) * ka.x); kp.y = kb[u].y * (1.f + (sigmoidf_(ap[u].y + a0.y) - 1.f) * ka.y);
            kp.z = kb[u].z * (1.f + (sigmoidf_(ap[u].z + a0.z) - 1.f) * ka.z); kp.w = kb[u].w * (1.f + (sigmoidf_(ap[u].w + a0.w) - 1.f) * ka.w);
            const float bon = row_sum16(rv[u].x * kp.x * rrk.x + rv[u].y * kp.y * rrk.y + rv[u].z * kp.z * rrk.z + rv[u].w * kp.w * rrk.w);
            uint2 o;
            o.x = pack2((yy.x + bon * vv[u].x) * gt[u].x, (yy.y + bon * vv[u].y) * gt[u].y);
            o.y = pack2((yy.z + bon * vv[u].z) * gt[u].z, (yy.w + bon * vv[u].w) * gt[u].w);
            if (ok[u]) *(uint2*)(MIXED + oo[u]) = o;
          }
        }
      }
}

__device__ __forceinline__ void ph_p16(KP p) {
  asm volatile("" : "+s"(p));
  char* lds = g_lds;
  int* s_unit = (int*)(g_lds + LDS_BYTES + 16);
  float* red = (float*)(g_lds + LDS_BYTES + 32);
  unsigned* ctr = (unsigned*)(p->ws + W_BAR) + 8192;
  const int tid = TID();
  const int G = gridDim.x;
  const int gtid = blockIdx.x * 256 + tid, gthreads = G * 256;
  u16* SCB = (u16*)(p->ws + W_SCB);
  float* MOD = (float*)(p->ws + W_MOD);
  u16* HA = (u16*)(p->ws + W_HA);
  u16* MIXED = (u16*)(p->ws + W_MIXED);
  float* X1 = (float*)(p->ws + W_X1);
  float* X2 = (float*)(p->ws + W_X2);
  float* Z = (float*)(p->ws + W_Z);
  float* QK = (float*)(p->ws + W_QK);
  u16* ACT = (u16*)(p->ws + W_ACT);
  u16* XMIX = (u16*)(p->ws + W_XMIX);
  (void)lds; (void)s_unit; (void)red; (void)ctr; (void)tid; (void)G; (void)gtid; (void)gthreads; (void)SCB; (void)MOD; (void)HA; (void)MIXED;
  (void)X1; (void)X2; (void)Z; (void)QK; (void)ACT; (void)XMIX;
      {
        const float* mod = MOD + (size_t)NB * 12288;
        gemm2_impl(MIXED, D, (const u16*)(p->ws + W_WT) + T_WO, D, 72, 16, D, D, 0, EPI_RESID(X1, X2, mod, 2), EPI_RESID_ATOMIC(X1, mod, 2), true);
      }
}

__device__ __forceinline__ void ph_normffn(KP p, int layer) {
  asm volatile("" : "+s"(p));
  char* lds = g_lds;
  int* s_unit = (int*)(g_lds + LDS_BYTES + 16);
  float* red = (float*)(g_lds + LDS_BYTES + 32);
  unsigned* ctr = (unsigned*)(p->ws + W_BAR) + 8192;
  const int tid = TID();
  const int G = gridDim.x;
  const int gtid = blockIdx.x * 256 + tid, gthreads = G * 256;
  u16* SCB = (u16*)(p->ws + W_SCB);
  float* MOD = (float*)(p->ws + W_MOD);
  u16* HA = (u16*)(p->ws + W_HA);
  u16* MIXED = (u16*)(p->ws + W_MIXED);
  float* X1 = (float*)(p->ws + W_X1);
  float* X2 = (float*)(p->ws + W_X2);
  float* Z = (float*)(p->ws + W_Z);
  float* QK = (float*)(p->ws + W_QK);
  u16* ACT = (u16*)(p->ws + W_ACT);
  u16* XMIX = (u16*)(p->ws + W_XMIX);
  (void)lds; (void)s_unit; (void)red; (void)ctr; (void)tid; (void)G; (void)gtid; (void)gthreads; (void)SCB; (void)MOD; (void)HA; (void)MIXED;
  (void)X1; (void)X2; (void)Z; (void)QK; (void)ACT; (void)XMIX;
  norm_pass<0>(p, red, [&](int r) { return (const float*)(X1 + (size_t)r * D); }, p->in[I_NFFN] + (size_t)layer * D, layer, 3);
}

__device__ __forceinline__ void ph_ffn1(KP p, int layer) {
  asm volatile("" : "+s"(p));
  char* lds = g_lds;
  int* s_unit = (int*)(g_lds + LDS_BYTES + 16);
  float* red = (float*)(g_lds + LDS_BYTES + 32);
  unsigned* ctr = (unsigned*)(p->ws + W_BAR) + 8192;
  const int tid = TID();
  const int G = gridDim.x;
  const int gtid = blockIdx.x * 256 + tid, gthreads = G * 256;
  u16* SCB = (u16*)(p->ws + W_SCB);
  float* MOD = (float*)(p->ws + W_MOD);
  u16* HA = (u16*)(p->ws + W_HA);
  u16* MIXED = (u16*)(p->ws + W_MIXED);
  float* X1 = (float*)(p->ws + W_X1);
  float* X2 = (float*)(p->ws + W_X2);
  float* Z = (float*)(p->ws + W_Z);
  float* QK = (float*)(p->ws + W_QK);
  u16* ACT = (u16*)(p->ws + W_ACT);
  u16* XMIX = (u16*)(p->ws + W_XMIX);
  (void)lds; (void)s_unit; (void)red; (void)ctr; (void)tid; (void)G; (void)gtid; (void)gthreads; (void)SCB; (void)MOD; (void)HA; (void)MIXED;
  (void)X1; (void)X2; (void)Z; (void)QK; (void)ACT; (void)XMIX;
    gemm2_job(HA, D, (const u16*)(p->ws + W_WT) + T_W1 + (size_t)layer * D * DFF, D, 72, 64, DFF, D, 0, EPI_ELEM(const float rl = fmaxf(v, 0.f); ACT[(unsigned)row * DFF + col] = f2bf(rl * rl);));
}

__device__ __forceinline__ void ph_ffn2(KP p, int layer) {
  asm volatile("" : "+s"(p));
  char* lds = g_lds;
  int* s_unit = (int*)(g_lds + LDS_BYTES + 16);
  float* red = (float*)(g_lds + LDS_BYTES + 32);
  unsigned* ctr = (unsigned*)(p->ws + W_BAR) + 8192;
  const int tid = TID();
  const int G = gridDim.x;
  const int gtid = blockIdx.x * 256 + tid, gthreads = G * 256;
  u16* SCB = (u16*)(p->ws + W_SCB);
  float* MOD = (float*)(p->ws + W_MOD);
  u16* HA = (u16*)(p->ws + W_HA);
  u16* MIXED = (u16*)(p->ws + W_MIXED);
  float* X1 = (float*)(p->ws + W_X1);
  float* X2 = (float*)(p->ws + W_X2);
  float* Z = (float*)(p->ws + W_Z);
  float* QK = (float*)(p->ws + W_QK);
  u16* ACT = (u16*)(p->ws + W_ACT);
  u16* XMIX = (u16*)(p->ws + W_XMIX);
  (void)lds; (void)s_unit; (void)red; (void)ctr; (void)tid; (void)G; (void)gtid; (void)gthreads; (void)SCB; (void)MOD; (void)HA; (void)MIXED;
  (void)X1; (void)X2; (void)Z; (void)QK; (void)ACT; (void)XMIX;
    {
      const float* mod = MOD + (size_t)layer * NB * 12288;
      gemm2_impl(ACT, DFF, (const u16*)(p->ws + W_WT) + T_W2 + (size_t)layer * DFF * D, DFF, 72, 16, D, DFF, 0, EPI_RESID(X2, X1, mod, 5), EPI_RESID_ATOMIC(X2, mod, 5), true);
    }
}

__device__ __forceinline__ void ph_final(KP p) {
  asm volatile("" : "+s"(p));
  char* lds = g_lds;
  int* s_unit = (int*)(g_lds + LDS_BYTES + 16);
  float* red = (float*)(g_lds + LDS_BYTES + 32);
  unsigned* ctr = (unsigned*)(p->ws + W_BAR) + 8192;
  const int tid = TID();
  const int G = gridDim.x;
  const int gtid = blockIdx.x * 256 + tid, gthreads = G * 256;
  u16* SCB = (u16*)(p->ws + W_SCB);
  float* MOD = (float*)(p->ws + W_MOD);
  u16* HA = (u16*)(p->ws + W_HA);
  u16* MIXED = (u16*)(p->ws + W_MIXED);
  float* X1 = (float*)(p->ws + W_X1);
  float* X2 = (float*)(p->ws + W_X2);
  float* Z = (float*)(p->ws + W_Z);
  float* QK = (float*)(p->ws + W_QK);
  u16* ACT = (u16*)(p->ws + W_ACT);
  u16* XMIX = (u16*)(p->ws + W_XMIX);
  (void)lds; (void)s_unit; (void)red; (void)ctr; (void)tid; (void)G; (void)gtid; (void)gthreads; (void)SCB; (void)MOD; (void)HA; (void)MIXED;
  (void)X1; (void)X2; (void)Z; (void)QK; (void)ACT; (void)XMIX;
  norm_pass<2>(p, red, [&](int r) { return (const float*)(X2 + (size_t)r * D); }, p->in[I_FNORM], 0, 0);
}

__global__ void __launch_bounds__(256, 2) fwd_megakernel(Params p_unused) {
  cg::grid_group grid = cg::this_grid();
  KP p = (KP)__builtin_amdgcn_kernarg_segment_ptr();
#if !USE_CG_SYNC
  if (TID() == 0) { *(uint4*)(g_lds + LDS_BYTES) = make_uint4(0u, 0u, 0u, 0u); }
  __syncthreads();
  XcdBarrier xb = xcd_barrier_post((unsigned*)(p->ws + W_BAR), (volatile LAS unsigned*)(g_lds + LDS_BYTES));
#endif
  if (gridDim.x == 0x7fffffffu) grid.sync();
  ph_p0(p);
  GSYNC();
#pragma unroll 1
  for (int ph = 1; ph <= 20; ++ph) {
    switch (ph) {
      case 1: ph_p1(p); break;
      case 2: ph_norm0(p); break;
      case 3: ph_p3(p); break;
      case 4: ph_p4(p); break;
      case 5: ph_p5(p); break;
      case 6: ph_p6(p); break;
      case 7: ph_p7(p); break;
      case 8: case 17: ph_normffn(p, ph == 17 ? 1 : 0); break;
      case 9: case 18: ph_ffn1(p, ph == 18 ? 1 : 0); break;
      case 10: case 19: ph_ffn2(p, ph == 19 ? 1 : 0); break;
      case 11: ph_norm1(p); break;
      case 12: ph_p12(p); break;
      case 13: ph_p13(p); break;
      case 14: ph_p14(p); break;
      case 15: ph_p15(p); break;
      case 16: ph_p16(p); break;
      default: ph_final(p); break;
    }
    if (ph < 20) GSYNC();
  }
}

extern "C" void kernel_launch(void* const* d_in, const int* in_sizes, int n_in, void* d_out, int out_size, void* d_ws, size_t ws_size,
                              hipStream_t stream) {
  static int grid_blocks = 0;
  if (!grid_blocks) {
    int dev = 0, cus = 0, per_cu = 0;
    hipGetDevice(&dev);
    hipDeviceGetAttribute(&cus, hipDeviceAttributeMultiprocessorCount, dev);
    hipOccupancyMaxActiveBlocksPerMultiprocessor(&per_cu, fwd_megakernel, 256, 0);
    if (per_cu > 4) per_cu = 4;
    if (per_cu < 1) per_cu = 1;
    grid_blocks = cus * per_cu;
  }
  if (ws_size < W_END) fprintf(stderr, "workspace too small: %zu < %zu\n", ws_size, (size_t)W_END);
  Params p{};
  for (int i = 0; i < N_IN; ++i) p.in[i] = (const float*)d_in[i];
  p.out = (float*)d_out;
  p.ws = (char*)d_ws;
  hipMemsetAsync(d_ws, 0, 65536, stream);
  void* args[] = {&p};
  hipError_t e = hipLaunchCooperativeKernel((void*)fwd_megakernel, dim3(grid_blocks), dim3(256), args, 0, stream);
  if (e != hipSuccess) fprintf(stderr, "cooperative launch failed: %s (grid %d)\n", hipGetErrorString(e), grid_blocks);
}
```
